# Optimizing an MI355X kernel written in HIP

```python
import math
import jax, jax.numpy as jnp
from jax import lax
import numpy as np

D_MODEL = 1024
BATCH = 4
SEQ = 8192
DEPTH = 2

GRID_W = 64
CTX_LEN = 256
HEAD_DIM = 64
ROPE_THETA = 10000.0
Q_BLOCK = 128
EPS = 1e-6
A_HEADS = D_MODEL // (2 * HEAD_DIM)
A_KV_HEADS = 2
A_GROUP = A_HEADS // A_KV_HEADS
B_HEADS = D_MODEL // (4 * HEAD_DIM)
AB_SPLITS = (A_HEADS * HEAD_DIM, A_KV_HEADS * HEAD_DIM, A_KV_HEADS * HEAD_DIM,
             B_HEADS * 2 * HEAD_DIM, B_HEADS * 2 * HEAD_DIM, B_HEADS * 2 * HEAD_DIM)
AB_IN = sum(AB_SPLITS)
AB_OUT = A_HEADS * HEAD_DIM + B_HEADS * 2 * HEAD_DIM
C_HEADS = D_MODEL // HEAD_DIM
NA_ROWS = 8
NA_COLS = 16
PEER_HEADS = 8
PEER_N_KEYS = 128
PEER_N_EXPERTS = PEER_N_KEYS * PEER_N_KEYS
PEER_TOPK = 16
PEER_QDIM = 256
PEER_CHUNK = 128

kernel_name = "hybrid_diffusion_gqa_diffattn_natten_peer"


def rms_norm(x, g):
    xf = x.astype(jnp.float32)
    y = xf * lax.rsqrt(jnp.mean(xf * xf, axis=-1, keepdims=True) + EPS)
    return (y * g.astype(jnp.float32)).astype(x.dtype)


def axial_rope_tables(n_tokens):
    t = jnp.arange(n_tokens)
    row = (t // GRID_W).astype(jnp.float32)
    col = (t % GRID_W).astype(jnp.float32)
    axis_dim = HEAD_DIM // 2
    freqs = 1.0 / (ROPE_THETA ** (jnp.arange(0, axis_dim, 2, dtype=jnp.float32) / axis_dim))
    ang = jnp.concatenate([row[:, None] * freqs, col[:, None] * freqs], axis=-1)
    return jnp.cos(ang), jnp.sin(ang)


def apply_axial_rope(x, cos, sin):
    B, S, H, D = x.shape
    xp = x.astype(jnp.float32).reshape(B, S, H, 2, 2, D // 4)
    c = cos.reshape(S, 1, 2, D // 4)
    s = sin.reshape(S, 1, 2, D // 4)
    x1 = xp[..., 0, :]
    x2 = xp[..., 1, :]
    out = jnp.stack([x1 * c - x2 * s, x1 * s + x2 * c], axis=-2)
    return out.reshape(B, S, H, D).astype(x.dtype)


def map_query_blocks(fn, qs):
    B, S = qs[0].shape[:2]
    nb = S // Q_BLOCK
    blocks = tuple(jnp.moveaxis(q.reshape((B, nb, Q_BLOCK) + q.shape[2:]), 1, 0) for q in qs)
    outs = lax.map(fn, blocks)
    return tuple(jnp.moveaxis(o, 0, 1).reshape((B, S) + o.shape[3:]) for o in outs)


def gqa_attend(q, k, v):
    s = jnp.einsum('bqhgd,bkhd->bhgqk', q, k) * (HEAD_DIM ** -0.5)
    p = jax.nn.softmax(s.astype(jnp.float32), axis=-1).astype(v.dtype)
    return jnp.einsum('bhgqk,bkhd->bqhgd', p, v)


def diff_attend(q, k, v, lam):
    s = jnp.einsum('bqhcd,bkhcd->bchqk', q, k) * (HEAD_DIM ** -0.5)
    p = jax.nn.softmax(s.astype(jnp.float32), axis=-1)
    p = (p[:, 0] - lam * p[:, 1]).astype(v.dtype)
    return jnp.einsum('bhqk,bkhe->bqhe', p, v)


def mixer_ab(h_lat, h_ctx, w_in, w_out, a_qn, a_kn, b_qn, b_kn, b_lam, b_subln, lam_init, cos, sin, need_ctx_out):
    def project(h, rope):
        B, L = h.shape[:2]
        qa, ka, va, qb, kb, vb = jnp.split(h @ w_in, np.cumsum(AB_SPLITS)[:-1].tolist(), axis=-1)
        qa = rms_norm(qa.reshape(B, L, A_HEADS, HEAD_DIM), a_qn)
        ka = rms_norm(ka.reshape(B, L, A_KV_HEADS, HEAD_DIM), a_kn)
        va = va.reshape(B, L, A_KV_HEADS, HEAD_DIM)
        qb = rms_norm(qb.reshape(B, L, 2 * B_HEADS, HEAD_DIM), b_qn)
        kb = rms_norm(kb.reshape(B, L, 2 * B_HEADS, HEAD_DIM), b_kn)
        vb = vb.reshape(B, L, B_HEADS, 2 * HEAD_DIM)
        if rope:
            qa, ka = apply_axial_rope(qa, cos, sin), apply_axial_rope(ka, cos, sin)
            qb, kb = apply_axial_rope(qb, cos, sin), apply_axial_rope(kb, cos, sin)
        qa = qa.reshape(B, L, A_KV_HEADS, A_GROUP, HEAD_DIM)
        qb = qb.reshape(B, L, B_HEADS, 2, HEAD_DIM)
        kb = kb.reshape(B, L, B_HEADS, 2, HEAD_DIM)
        return qa, ka, va, qb, kb, vb

    lf = b_lam.astype(jnp.float32)
    lam = jnp.exp(jnp.sum(lf[0] * lf[1])) - jnp.exp(jnp.sum(lf[2] * lf[3])) + lam_init

    qa_l, ka_l, va_l, qb_l, kb_l, vb_l = project(h_lat, True)
    qa_c, ka_c, va_c, qb_c, kb_c, vb_c = project(h_ctx, False)
    ka_all = jnp.concatenate([ka_c, ka_l], axis=1)
    va_all = jnp.concatenate([va_c, va_l], axis=1)
    kb_all = jnp.concatenate([kb_c, kb_l], axis=1)
    vb_all = jnp.concatenate([vb_c, vb_l], axis=1)

    def block(qs):
        qa_blk, qb_blk = qs
        return gqa_attend(qa_blk, ka_all, va_all), diff_attend(qb_blk, kb_all, vb_all, lam)

    def merge(oa, ob):
        B, L = oa.shape[:2]
        ob = rms_norm(ob, b_subln) * (1.0 - lam_init)
        o = jnp.concatenate([oa.reshape(B, L, -1), ob.reshape(B, L, -1)], axis=-1)
        return o @ w_out

    oa_l, ob_l = map_query_blocks(block, (qa_l, qb_l))
    o_lat = merge(oa_l, ob_l)
    o_ctx = None
    if need_ctx_out:
        o_ctx = merge(gqa_attend(qa_c, ka_c, va_c), diff_attend(qb_c, kb_c, vb_c, lam))
    return o_lat, o_ctx


def mixer_c(h_lat, h_ctx, w_in, w_out, qn, kn, rpb, need_ctx_out):
    def project(h):
        B, L = h.shape[:2]
        q, k, v = jnp.split(h @ w_in, 3, axis=-1)
        q = rms_norm(q.reshape(B, L, C_HEADS, HEAD_DIM), qn)
        k = rms_norm(k.reshape(B, L, C_HEADS, HEAD_DIM), kn)
        return q, k, v.reshape(B, L, C_HEADS, HEAD_DIM)

    q, k, v = project(h_lat)
    qc, kc, vc = project(h_ctx)
    B, S = h_lat.shape[:2]
    rows = S // GRID_W
    wr = min(NA_ROWS, rows)
    scale = HEAD_DIM ** -0.5
    qg = q.reshape(B, rows, GRID_W, C_HEADS, HEAD_DIM)
    kg = k.reshape(B, rows, GRID_W, C_HEADS, HEAD_DIM)
    vg = v.reshape(B, rows, GRID_W, C_HEADS, HEAD_DIM)
    r_all = jnp.arange(rows)
    row_start = jnp.clip(r_all - wr // 2, 0, rows - wr)
    j = jnp.arange(GRID_W)
    col_start = jnp.clip(j - NA_COLS // 2, 0, GRID_W - NA_COLS)
    col_idx = col_start[:, None] + jnp.arange(NA_COLS)
    dc_idx = col_idx - j[:, None] + (NA_COLS - 1)

    def row_block(args):
        q_row, r_i, rs_i = args
        band_k = lax.dynamic_slice_in_dim(kg, rs_i, wr, axis=1)
        band_v = lax.dynamic_slice_in_dim(vg, rs_i, wr, axis=1)
        kw = band_k[:, :, col_idx]
        vw = band_v[:, :, col_idx]
        dr_idx = rs_i + jnp.arange(wr) - r_i + (NA_ROWS - 1)
        bias = jnp.transpose(rpb[:, dr_idx][:, :, dc_idx], (0, 2, 1, 3))
        s_win = jnp.einsum('bqhd,brqchd->bhqrc', q_row, kw) * scale + bias[None]
        s_win = s_win.reshape(B, C_HEADS, GRID_W, wr * NA_COLS)
        s_ctx = jnp.einsum('bqhd,bkhd->bhqk', q_row, kc) * scale
        p = jax.nn.softmax(jnp.concatenate([s_win, s_ctx], axis=-1).astype(jnp.float32), axis=-1)
        p = p.astype(v.dtype)
        p_win = p[..., :wr * NA_COLS].reshape(B, C_HEADS, GRID_W, wr, NA_COLS)
        p_ctx = p[..., wr * NA_COLS:]
        return (jnp.einsum('bhqrc,brqchd->bqhd', p_win, vw)
                + jnp.einsum('bhqk,bkhd->bqhd', p_ctx, vc))

    o = lax.map(row_block, (jnp.moveaxis(qg, 1, 0), r_all, row_start))
    o_lat = jnp.moveaxis(o, 0, 1).reshape(B, S, C_HEADS * HEAD_DIM) @ w_out
    o_ctx = None
    if need_ctx_out:
        oc = gqa_attend(qc[:, :, :, None], kc, vc)
        o_ctx = oc.reshape(B, qc.shape[1], C_HEADS * HEAD_DIM) @ w_out
    return o_lat, o_ctx


def peer_ffn(h, w_q, sub_keys, expert_u, expert_v):
    B, L, D = h.shape
    xs = h.reshape(-1, PEER_CHUNK, D)

    def chunk(xc):
        T = xc.shape[0]
        qry = (xc @ w_q).reshape(T, PEER_HEADS, 2, PEER_QDIM // 2)
        s = jnp.einsum('thpd,hpnd->thpn', qry, sub_keys).astype(jnp.float32)
        s1, i1 = lax.top_k(s[:, :, 0], PEER_TOPK)
        s2, i2 = lax.top_k(s[:, :, 1], PEER_TOPK)
        cand = (s1[..., :, None] + s2[..., None, :]).reshape(T, PEER_HEADS, PEER_TOPK * PEER_TOPK)
        cand_idx = (i1[..., :, None] * PEER_N_KEYS + i2[..., None, :]).reshape(T, PEER_HEADS, PEER_TOPK * PEER_TOPK)
        top_s, top_pos = lax.top_k(cand, PEER_TOPK)
        eidx = jnp.take_along_axis(cand_idx, top_pos, axis=-1)
        g = jax.nn.softmax(top_s, axis=-1)
        u = jnp.take(expert_u, eidx, axis=0)
        a = jax.nn.gelu(jnp.einsum('td,thkd->thk', xc, u).astype(jnp.float32))
        v = jnp.take(expert_v, eidx, axis=0)
        return jnp.einsum('thk,thkd->td', (g * a).astype(xc.dtype), v)

    return lax.map(chunk, xs).reshape(B, L, D)


def setup_inputs(seed: int = 0) -> dict:
    key = jax.random.key(seed)
    ks = jax.random.split(key, 24)
    n_even = (DEPTH + 1) // 2
    n_odd = DEPTH // 2
    f32 = jnp.float32
    nrm = lambda k, shape, s: jax.random.normal(k, shape, f32) * s
    gain = lambda k, shape: 1.0 + 0.05 * jax.random.normal(k, shape, f32)
    return {
        "x": nrm(ks[0], (BATCH, SEQ, D_MODEL), 1.0),
        "c": nrm(ks[1], (BATCH, D_MODEL), 1.0),
        "ctx": nrm(ks[2], (BATCH, CTX_LEN, D_MODEL), 1.0),
        "c_ctx": nrm(ks[3], (D_MODEL,), 1.0),
        "ada_w": nrm(ks[4], (DEPTH, D_MODEL, 6 * D_MODEL), D_MODEL ** -0.5),
        "ada_b": nrm(ks[5], (DEPTH, 6 * D_MODEL), 0.02),
        "norm_g": gain(ks[6], (DEPTH, 2, D_MODEL)),
        "ab_w_in": nrm(ks[7], (n_even, D_MODEL, AB_IN), D_MODEL ** -0.5),
        "ab_w_out": nrm(ks[8], (n_even, AB_OUT, D_MODEL), AB_OUT ** -0.5),
        "a_q_norm": gain(ks[9], (n_even, HEAD_DIM)),
        "a_k_norm": gain(ks[10], (n_even, HEAD_DIM)),
        "b_q_norm": gain(ks[11], (n_even, HEAD_DIM)),
        "b_k_norm": gain(ks[12], (n_even, HEAD_DIM)),
        "b_lambda": nrm(ks[13], (n_even, 4, HEAD_DIM), 0.1),
        "b_subln": gain(ks[14], (n_even, 2 * HEAD_DIM)),
        "c_w_in": nrm(ks[15], (n_odd, D_MODEL, 3 * C_HEADS * HEAD_DIM), D_MODEL ** -0.5),
        "c_w_out": nrm(ks[16], (n_odd, C_HEADS * HEAD_DIM, D_MODEL), (C_HEADS * HEAD_DIM) ** -0.5),
        "c_q_norm": gain(ks[17], (n_odd, HEAD_DIM)),
        "c_k_norm": gain(ks[18], (n_odd, HEAD_DIM)),
        "c_rpb": nrm(ks[19], (n_odd, C_HEADS, 2 * NA_ROWS - 1, 2 * NA_COLS - 1), 0.2),
        "peer_w_q": nrm(ks[20], (DEPTH, D_MODEL, PEER_HEADS * PEER_QDIM), D_MODEL ** -0.5),
        "peer_keys": nrm(ks[21], (DEPTH, PEER_HEADS, 2, PEER_N_KEYS, PEER_QDIM // 2), (PEER_QDIM // 2) ** -0.5),
        "peer_u": nrm(ks[22], (DEPTH, PEER_N_EXPERTS, D_MODEL), D_MODEL ** -0.5),
        "peer_v": nrm(ks[23], (DEPTH, PEER_N_EXPERTS, D_MODEL), 0.1),
    }


def reference(x, c, ctx, c_ctx, ada_w, ada_b, norm_g, ab_w_in, ab_w_out, a_q_norm, a_k_norm,
              b_q_norm, b_k_norm, b_lambda, b_subln, c_w_in, c_w_out, c_q_norm, c_k_norm, c_rpb,
              peer_w_q, peer_keys, peer_u, peer_v):
    B, S, D = x.shape
    cos, sin = axial_rope_tables(S)
    for l in range(DEPTH):
        last = l == DEPTH - 1
        m_lat = (jax.nn.silu(c) @ ada_w[l] + ada_b[l]).reshape(B, 6, 1, D)
        m_ctx = (jax.nn.silu(c_ctx) @ ada_w[l] + ada_b[l]).reshape(6, 1, D)
        h_lat = rms_norm(x, norm_g[l, 0]) * (1.0 + m_lat[:, 1]) + m_lat[:, 0]
        h_ctx = rms_norm(ctx, norm_g[l, 0]) * (1.0 + m_ctx[1]) + m_ctx[0]
        i = l // 2
        if l % 2 == 0:
            lam_init = 0.8 - 0.6 * math.exp(-0.3 * l)
            o_lat, o_ctx = mixer_ab(h_lat, h_ctx, ab_w_in[i], ab_w_out[i], a_q_norm[i], a_k_norm[i],
                                    b_q_norm[i], b_k_norm[i], b_lambda[i], b_subln[i], lam_init,
                                    cos, sin, not last)
        else:
            o_lat, o_ctx = mixer_c(h_lat, h_ctx, c_w_in[i], c_w_out[i], c_q_norm[i], c_k_norm[i],
                                   c_rpb[i], not last)
        x = x + m_lat[:, 2] * o_lat
        h_lat = rms_norm(x, norm_g[l, 1]) * (1.0 + m_lat[:, 4]) + m_lat[:, 3]
        x = x + m_lat[:, 5] * peer_ffn(h_lat, peer_w_q[l], peer_keys[l], peer_u[l], peer_v[l])
        if not last:
            ctx = ctx + m_ctx[2] * o_ctx
            h_ctx = rms_norm(ctx, norm_g[l, 1]) * (1.0 + m_ctx[4]) + m_ctx[3]
            ctx = ctx + m_ctx[5] * peer_ffn(h_ctx, peer_w_q[l], peer_keys[l], peer_u[l], peer_v[l])
    return x
```

```cpp
#include <hip/hip_runtime.h>
#include <hip/hip_cooperative_groups.h>
#include <cstdio>
namespace cg = cooperative_groups;

#define DI __device__ __forceinline__
typedef unsigned short ushort_t;
using bf16x8 = __attribute__((ext_vector_type(8))) short;
using f32x16 = __attribute__((ext_vector_type(16))) float;
using u32x4 = __attribute__((ext_vector_type(4))) unsigned;
using f32x2 = __attribute__((ext_vector_type(2))) float;
using u32x2 = __attribute__((ext_vector_type(2))) unsigned;
#define MFMA32(a, b, c) __builtin_amdgcn_mfma_f32_32x32x16_bf16((a), (b), (c), 0, 0, 0)

constexpr int DM = 1024;
constexpr int LKB = 8448;
constexpr int NTOK = 4 * LKB;
constexpr int SMEM_BYTES = 66560;
constexpr float LOG2E = 1.4426950408889634f;

struct Params {
  const float *x, *c, *ctx, *c_ctx, *ada_w, *ada_b, *norm_g, *ab_w_in, *ab_w_out, *a_qn, *a_kn, *b_qn, *b_kn, *b_lam,
      *b_subln, *c_w_in, *c_w_out, *c_qn, *c_kn, *c_rpb, *peer_wq, *peer_keys, *peer_u, *peer_v;
  float* out;
  char* ws;
};
constexpr size_t al256(size_t x) { return (x + 255) & ~(size_t)255; }
constexpr size_t OFF_MOD = 0;
constexpr size_t OFF_SCAL = OFF_MOD + al256(2 * 5 * 6144 * 4);
constexpr size_t OFF_BAR = OFF_SCAL + 256;
constexpr size_t OFF_ROPE = OFF_BAR + 16384;
constexpr size_t OFF_WABIN = OFF_ROPE + al256(128 * 16 * 8);
constexpr size_t OFF_WABOUT = OFF_WABIN + (size_t)2304 * 1024 * 2;
constexpr size_t OFF_WCIN = OFF_WABOUT + (size_t)1024 * 1024 * 2;
constexpr size_t OFF_WCOUT = OFF_WCIN + (size_t)3072 * 1024 * 2;
constexpr size_t OFF_WPQ = OFF_WCOUT + (size_t)1024 * 1024 * 2;
constexpr size_t OFF_KEYS = OFF_WPQ + (size_t)2 * 2048 * 1024 * 2;
constexpr size_t OFF_H = OFF_KEYS + (size_t)2 * 8 * 2 * 128 * 128 * 2;
constexpr size_t OFF_QB = OFF_H + (size_t)NTOK * 1024 * 2;
constexpr size_t OFF_KB = OFF_QB + (size_t)NTOK * 1024 * 2;
constexpr size_t OFF_VT = OFF_KB + (size_t)NTOK * 1024 * 2;
constexpr size_t OFF_R = OFF_VT + (size_t)NTOK * 1024 * 2;
constexpr size_t WS_TOTAL = OFF_R + (size_t)NTOK * 1024 * 4;
#define P_MOD ((float*)(p.ws + OFF_MOD))
#define P_SCAL ((float*)(p.ws + OFF_SCAL))
#define P_ROPE ((float2*)(p.ws + OFF_ROPE))
#define P_WABIN ((ushort_t*)(p.ws + OFF_WABIN))
#define P_WABOUT ((ushort_t*)(p.ws + OFF_WABOUT))
#define P_WCIN ((ushort_t*)(p.ws + OFF_WCIN))
#define P_WCOUT ((ushort_t*)(p.ws + OFF_WCOUT))
#define P_WPQ ((ushort_t*)(p.ws + OFF_WPQ))
#define P_KEYS ((ushort_t*)(p.ws + OFF_KEYS))
#define P_H ((ushort_t*)(p.ws + OFF_H))
#define P_QB ((ushort_t*)(p.ws + OFF_QB))
#define P_KB ((ushort_t*)(p.ws + OFF_KB))
#define P_VT ((ushort_t*)(p.ws + OFF_VT))
#define P_R ((float*)(p.ws + OFF_R))
#define P_U8 ((unsigned char*)(p.ws + OFF_QB))
#define P_V8 ((unsigned char*)(p.ws + OFF_QB) + (size_t)16384 * 1024)
#define P_UIS ((float*)(p.ws + OFF_QB + (size_t)2 * 16384 * 1024))
#define P_VIS ((float*)(p.ws + OFF_QB + (size_t)2 * 16384 * 1024 + 65536))
#define P_BAR ((unsigned*)(p.ws + OFF_BAR))
#define P_TOPK ((unsigned*)(p.ws + OFF_KB))

DI int opaque_tid() { int t = threadIdx.x; asm volatile("" : "+v"(t)); return t; }
DI float bf_lo(unsigned u) { return __uint_as_float(u << 16); }
DI float bf_hi(unsigned u) { return __uint_as_float(u & 0xffff0000u); }
DI unsigned pack2(float a, float b) {
  typedef __bf16 bf2_t __attribute__((ext_vector_type(2)));
  typedef float f2_t __attribute__((ext_vector_type(2)));
  f2_t v = {a, b};
  bf2_t r = __builtin_convertvector(v, bf2_t);
  return __builtin_bit_cast(unsigned, r);
}
DI ushort_t tobf(float a) { return (ushort_t)(pack2(a, 0.f) & 0xffffu); }
DI int crow(int reg, int h) { return (reg & 3) + 8 * (reg >> 2) + 4 * h; }
DI int swz128(int row, int chunk) { return row * 128 + ((chunk ^ ((row >> 1) & 7)) << 4); }
DI int swz256(int row, int chunk) { return row * 256 + ((chunk ^ (row & 15)) << 4); }
template <int CTRL>
DI float dpp_f(float v) {
  return __builtin_bit_cast(float, __builtin_amdgcn_update_dpp(0, __builtin_bit_cast(int, v), CTRL, 0xf, 0xf, false));
}
DI float wave_sum(float v) {
#pragma unroll
  for (int o = 32; o >= 1; o >>= 1) v += __shfl_xor(v, o);
  return v;
}
DI float wave_max(float v) {
#pragma unroll
  for (int o = 32; o >= 1; o >>= 1) v = fmaxf(v, __shfl_xor(v, o));
  return v;
}

#define XB_TMO      128
#define XB_XCNT(j)  (256  + 64 * (j))
#define XB_XSUB(j)  (1280 + 64 * (j))
#define XB_XGEN(j)  (2304 + 64 * (j))
#define XB_TOP      3328
#define XB_TOPGEN   3392
#define XCD_BAR_WORDS 3456
#define XB_SPIN_CAP (1u << 22)
#define LAS __attribute__((address_space(3)))
DI unsigned xb_ld(unsigned* p) { return __hip_atomic_load(p, __ATOMIC_RELAXED, __HIP_MEMORY_SCOPE_AGENT); }
DI unsigned xb_add(unsigned* p, unsigned v) { return __hip_atomic_fetch_add(p, v, __ATOMIC_RELAXED, __HIP_MEMORY_SCOPE_AGENT); }
DI unsigned xb_xcc_id() { return (unsigned)__builtin_amdgcn_s_getreg((3 << 11) | 20) & 0xFu; }
#define XB_SPIN(cond, bar) do { unsigned _sp = 0; while (cond) { __builtin_amdgcn_s_sleep(1); \
    if ((++_sp & 255u) == 0u) { if (xb_ld(&(bar)[XB_TMO])) break; if (_sp > XB_SPIN_CAP) { atomicAdd(&(bar)[XB_TMO], 1u); break; } } } } while (0)
struct XcdBarrier { unsigned* bar; unsigned x; volatile LAS unsigned* st; };
DI XcdBarrier xcd_barrier_post(unsigned* bar, volatile LAS unsigned* st) {
  XcdBarrier b; b.bar = bar; b.x = xb_xcc_id(); b.st = st;
  if (threadIdx.x == 0) (void)xb_add(&bar[XB_XCNT(b.x)], 1u);
  return b;
}
DI void xcd_barrier_complete(unsigned* bar, unsigned x, unsigned& nloc, unsigned& nx) {
  const unsigned G = gridDim.x;
  unsigned sum, cnt, mine, sp = 0u;
  for (;;) {
    sum = 0u; cnt = 0u; mine = 0u;
#pragma unroll
    for (unsigned j = 0; j < 16; ++j) { const unsigned c = xb_ld(&bar[XB_XCNT(j)]); sum += c; cnt += (c > 0u) ? 1u : 0u; mine = (j == x) ? c : mine; }
    if (sum == G) break;
    __builtin_amdgcn_s_sleep(1);
    if ((++sp & 255u) == 0u) { if (xb_ld(&bar[XB_TMO])) break; if (sp > XB_SPIN_CAP) { atomicAdd(&bar[XB_TMO], 1u); break; } }
  }
  nloc = mine > 0u ? mine : 1u; nx = cnt > 0u ? cnt : 1u;
}
DI void xcd_barrier(const XcdBarrier& b) {
  asm volatile("s_waitcnt vmcnt(0)" ::: "memory");
  __syncthreads();
  if (threadIdx.x == 0) {
    unsigned* bar = b.bar;
    __builtin_amdgcn_s_waitcnt(0);
    unsigned nloc = b.st[0], nx = b.st[1];
    if (nloc == 0u) { xcd_barrier_complete(bar, b.x, nloc, nx); b.st[0] = nloc; b.st[1] = nx; }
    const unsigned old = xb_add(&bar[XB_XSUB(b.x)], 1u);
    const unsigned gen = old / nloc;
    if (old + 1u == (gen + 1u) * nloc) {
      __builtin_amdgcn_fence(__ATOMIC_RELEASE, "agent");
      asm volatile("s_waitcnt vmcnt(0)" ::: "memory");
      const unsigned og = xb_add(&bar[XB_TOP], 1u);
      const unsigned tg = og / nx;
      if (og + 1u == (tg + 1u) * nx) xb_add(&bar[XB_TOPGEN], 1u);
      else XB_SPIN(xb_ld(&bar[XB_TOPGEN]) == tg, bar);
      __builtin_amdgcn_fence(__ATOMIC_ACQUIRE, "agent");
      xb_add(&bar[XB_XGEN(b.x)], 1u);
      asm volatile("s_waitcnt vmcnt(0)" ::: "memory");
    } else {
      XB_SPIN(xb_ld(&bar[XB_XGEN(b.x)]) == gen, bar);
      __builtin_amdgcn_fence(__ATOMIC_ACQUIRE, "agent");
      asm volatile("s_waitcnt vmcnt(0)" ::: "memory");
    }
  }
  __syncthreads();
}

DI void convert_i8_rows(const float* __restrict__ src, unsigned char* __restrict__ dst, float* __restrict__ inv_scale) {
  const int tid = opaque_tid();
  const int lane = tid & 63;
  const int wave = (blockIdx.x * 256 + tid) >> 6, nw = gridDim.x * 4;
  for (int row = wave; row < 16384; row += nw) {
    float4 v[4];
    float mx = 0.f;
#pragma unroll
    for (int i = 0; i < 4; ++i) {
      v[i] = *(const float4*)(src + (size_t)row * 1024 + i * 256 + lane * 4);
      mx = fmaxf(mx, fmaxf(fmaxf(fabsf(v[i].x), fabsf(v[i].y)), fmaxf(fabsf(v[i].z), fabsf(v[i].w))));
    }
    mx = wave_max(mx);
    const float sc = (mx > 1e-30f) ? 127.f / mx : 1.f;
#pragma unroll
    for (int i = 0; i < 4; ++i) {
      const unsigned w = ((unsigned)__float2int_rn(v[i].x * sc) & 255u) | (((unsigned)__float2int_rn(v[i].y * sc) & 255u) << 8) |
                         (((unsigned)__float2int_rn(v[i].z * sc) & 255u) << 16) | (((unsigned)__float2int_rn(v[i].w * sc) & 255u) << 24);
      *(unsigned*)(dst + (size_t)row * 1024 + i * 256 + lane * 4) = w;
    }
    if (lane == 0) inv_scale[row] = (mx > 1e-30f) ? mx * (1.f / 127.f) : 1.f;
  }
}

DI void convert_fp4_rows(const float* __restrict__ src, unsigned char* __restrict__ dst, float* __restrict__ inv_scale) {
  const int tid = opaque_tid();
  const int lane = tid & 63;
  const int wave = (blockIdx.x * 256 + tid) >> 6, nw = gridDim.x * 4;
  for (int row = wave; row < 16384; row += nw) {
    float4 v[4];
    float mx = 0.f;
#pragma unroll
    for (int i = 0; i < 4; ++i) {
      v[i] = *(const float4*)(src + (size_t)row * 1024 + (i >> 1) * 512 + lane * 8 + (i & 1) * 4);
      mx = fmaxf(mx, fmaxf(fmaxf(fabsf(v[i].x), fabsf(v[i].y)), fmaxf(fabsf(v[i].z), fabsf(v[i].w))));
    }
    mx = wave_max(mx);
    const float sc = (mx > 1e-30f) ? 6.f / mx : 1.f;
#pragma unroll
    for (int ps = 0; ps < 2; ++ps) {
      unsigned w = 0u;
      w = __builtin_amdgcn_cvt_scalef32_pk_fp4_f32(w, v[2 * ps].x * sc, v[2 * ps].y * sc, 1.0f, 0);
      w = __builtin_amdgcn_cvt_scalef32_pk_fp4_f32(w, v[2 * ps].z * sc, v[2 * ps].w * sc, 1.0f, 1);
      w = __builtin_amdgcn_cvt_scalef32_pk_fp4_f32(w, v[2 * ps + 1].x * sc, v[2 * ps + 1].y * sc, 1.0f, 2);
      w = __builtin_amdgcn_cvt_scalef32_pk_fp4_f32(w, v[2 * ps + 1].z * sc, v[2 * ps + 1].w * sc, 1.0f, 3);
      *(unsigned*)(dst + (size_t)row * 512 + ps * 256 + lane * 4) = w;
    }
    if (lane == 0) inv_scale[row] = (mx > 1e-30f) ? mx * (1.f / 6.f) : 1.f;
  }
}

DI void transpose_convert(const float* __restrict__ src, ushort_t* __restrict__ dst, int K, int N, float* tile) {
  const int tid = opaque_tid();
  const int tilesN = N / 64, nt = tilesN * (K / 64);
  for (int t = blockIdx.x; t < nt; t += gridDim.x) {
    const int k0 = (t / tilesN) * 64, n0 = (t % tilesN) * 64;
#pragma unroll
    for (int ps = 0; ps < 4; ++ps) {
      const int r = ps * 16 + (tid >> 4), c4 = (tid & 15) * 4;
      const float4 v = *(const float4*)(src + (size_t)(k0 + r) * N + n0 + c4);
      tile[r * 65 + c4 + 0] = v.x; tile[r * 65 + c4 + 1] = v.y; tile[r * 65 + c4 + 2] = v.z; tile[r * 65 + c4 + 3] = v.w;
    }
    __syncthreads();
    const int n = tid >> 2, kc = (tid & 3) * 16;
    unsigned w[8];
#pragma unroll
    for (int i = 0; i < 8; ++i) w[i] = pack2(tile[(kc + 2 * i) * 65 + n], tile[(kc + 2 * i + 1) * 65 + n]);
    uint4* d = (uint4*)(dst + (size_t)(n0 + n) * K + k0 + kc);
    d[0] = make_uint4(w[0], w[1], w[2], w[3]);
    d[1] = make_uint4(w[4], w[5], w[6], w[7]);
    __syncthreads();
  }
}

DI void convert_flat(const float* __restrict__ src, ushort_t* __restrict__ dst, size_t n4) {
  const size_t gt = (size_t)blockIdx.x * 256 + opaque_tid(), gs = (size_t)gridDim.x * 256;
  for (size_t i = gt; i < n4; i += gs) {
    const float4 v = ((const float4*)src)[i];
    ((uint2*)dst)[i] = make_uint2(pack2(v.x, v.y), pack2(v.z, v.w));
  }
}

DI void phase_prologue(const Params& p, char* smem) {
  const int tid = opaque_tid();
  float* sl = (float*)smem;
  float* red = sl + 5 * 1024;
  for (int item = blockIdx.x; item < 192; item += gridDim.x) {
    const int l = item / 96, n0 = (item % 96) * 64;
    for (int i = tid; i < 5 * 1024; i += 256) {
      const int r = i >> 10, k = i & 1023;
      const float v = (r < 4) ? p.c[r * 1024 + k] : p.c_ctx[k];
      sl[i] = v / (1.f + expf(-v));
    }
    __syncthreads();
    const int kg = tid >> 6, col = tid & 63;
    float a0 = 0, a1 = 0, a2 = 0, a3 = 0, a4 = 0;
    const float* w = p.ada_w + (size_t)l * 1024 * 6144 + n0 + col;
#pragma unroll 8
    for (int k = kg * 256; k < kg * 256 + 256; ++k) {
      const float wv = w[(size_t)k * 6144];
      a0 += sl[k] * wv; a1 += sl[1024 + k] * wv; a2 += sl[2048 + k] * wv; a3 += sl[3072 + k] * wv; a4 += sl[4096 + k] * wv;
    }
    red[(kg * 5 + 0) * 64 + col] = a0; red[(kg * 5 + 1) * 64 + col] = a1; red[(kg * 5 + 2) * 64 + col] = a2;
    red[(kg * 5 + 3) * 64 + col] = a3; red[(kg * 5 + 4) * 64 + col] = a4;
    __syncthreads();
    for (int i = tid; i < 320; i += 256) {
      const int r = i >> 6, cc = i & 63;
      const float s = red[(0 * 5 + r) * 64 + cc] + red[(1 * 5 + r) * 64 + cc] + red[(2 * 5 + r) * 64 + cc] + red[(3 * 5 + r) * 64 + cc];
      P_MOD[(l * 5 + r) * 6144 + n0 + cc] = s + p.ada_b[l * 6144 + n0 + cc];
    }
    __syncthreads();
  }
  float* tile = (float*)smem;
  transpose_convert(p.ab_w_in, P_WABIN, 1024, 2304, tile);
  transpose_convert(p.ab_w_out, P_WABOUT, 1024, 1024, tile);
  transpose_convert(p.c_w_in, P_WCIN, 1024, 3072, tile);
  transpose_convert(p.c_w_out, P_WCOUT, 1024, 1024, tile);
  transpose_convert(p.peer_wq, P_WPQ, 1024, 2048, tile);
  transpose_convert(p.peer_wq + (size_t)1024 * 2048, P_WPQ + (size_t)2048 * 1024, 1024, 2048, tile);
  convert_flat(p.peer_keys, P_KEYS, (size_t)2 * 8 * 2 * 128 * 128 / 4);
  const int gt = blockIdx.x * 256 + tid;
  if (gt < 128 * 16) {
    const int pos = gt >> 4, fi = gt & 15;
    const float freq = 1.0f / powf(10000.f, (float)(2 * fi) / 32.f);
    const float ang = (float)pos * freq;
    P_ROPE[gt] = make_float2(cosf(ang), sinf(ang));
  }
  if (blockIdx.x == gridDim.x - 1) {
    float* rb = (float*)smem;
    float mv[8];
    const float* gv[6] = {p.a_qn, p.a_kn, p.b_qn, p.b_kn, p.c_qn, p.c_kn};
#pragma unroll
    for (int k = 0; k < 6; ++k) mv[k] = (tid < 64) ? fabsf(gv[k][tid]) : 0.f;
    float mr = 0.f;
    for (int i = tid; i < 16 * 465; i += 256) mr = fmaxf(mr, fabsf(p.c_rpb[i]));
    mv[6] = mr; mv[7] = 0.f;
    __syncthreads();
#pragma unroll
    for (int k = 0; k < 8; ++k) rb[k * 256 + tid] = mv[k];
    __syncthreads();
    if (tid < 8) {
      float mxv = 0.f;
      for (int i = 0; i < 256; ++i) mxv = fmaxf(mxv, rb[tid * 256 + i]);
      rb[2048 + tid] = mxv;
    }
    __syncthreads();
    if (tid == 0) {
      const float c8 = 8.f * LOG2E;
      P_SCAL[1] = c8 * rb[2048 + 0] * rb[2048 + 1];
      P_SCAL[2] = c8 * rb[2048 + 2] * rb[2048 + 3];
      P_SCAL[3] = c8 * rb[2048 + 4] * rb[2048 + 5] + LOG2E * rb[2048 + 6];
    }
    __syncthreads();
  }
  if (gt == 0) {
    float s1 = 0, s2 = 0;
    for (int i = 0; i < 64; ++i) { s1 += p.b_lam[i] * p.b_lam[64 + i]; s2 += p.b_lam[128 + i] * p.b_lam[192 + i]; }
    P_SCAL[0] = expf(s1) - expf(s2) + 0.2f;
  }
}

DI void phase_norm(const Params& p, int layer, int which) {
  const int tid = opaque_tid();
  const int lane = tid & 63;
  const int wave = (blockIdx.x * 256 + tid) >> 6, nw = gridDim.x * 4;
  const float* g = p.norm_g + (layer * 2 + which) * 1024;
  for (int u = wave; u < NTOK; u += nw) {
    const int b = u / LKB, pp = u - b * LKB;
    const bool isctx = pp < 256;
    if (layer == 1 && which == 1 && isctx) continue;
    const float* src;
    if (layer == 0 && which == 0) src = isctx ? p.ctx + ((size_t)b * 256 + pp) * 1024 : p.x + ((size_t)b * 8192 + (pp - 256)) * 1024;
    else src = P_R + (size_t)u * 1024;
    const int mr = isctx ? 4 : b;
    const float* shift = P_MOD + (layer * 5 + mr) * 6144 + (which ? 3 : 0) * 1024;
    const float* scale = shift + 1024;
    float4 v[4];
    float ss = 0.f;
#pragma unroll
    for (int i = 0; i < 4; ++i) {
      v[i] = *(const float4*)(src + i * 256 + lane * 4);
      ss += v[i].x * v[i].x + v[i].y * v[i].y + v[i].z * v[i].z + v[i].w * v[i].w;
    }
    ss = wave_sum(ss);
    const float rn = rsqrtf(ss * (1.f / 1024.f) + 1e-6f);
#pragma unroll
    for (int i = 0; i < 4; ++i) {
      const int col = i * 256 + lane * 4;
      const float4 g4 = *(const float4*)(g + col), sc = *(const float4*)(scale + col), sh = *(const float4*)(shift + col);
      const float y0 = v[i].x * rn * g4.x * (1.f + sc.x) + sh.x;
      const float y1 = v[i].y * rn * g4.y * (1.f + sc.y) + sh.y;
      const float y2 = v[i].z * rn * g4.z * (1.f + sc.z) + sh.z;
      const float y3 = v[i].w * rn * g4.w * (1.f + sc.w) + sh.w;
      *(uint2*)(P_H + (size_t)u * 1024 + col) = make_uint2(pack2(y0, y1), pack2(y2, y3));
    }
  }
}

DI void gemm_load(const ushort_t* __restrict__ P, const ushort_t* __restrict__ Q, int kt, int srow, int sch, u32x4 (&pr)[4], u32x4 (&qr)[4]) {
#pragma unroll
  for (int ps = 0; ps < 4; ++ps) {
    pr[ps] = *(const u32x4*)(P + (size_t)(srow + 32 * ps) * 1024 + kt * 64 + sch * 8);
    qr[ps] = *(const u32x4*)(Q + (size_t)(srow + 32 * ps) * 1024 + kt * 64 + sch * 8);
  }
}
DI void gemm_write(char* buf, int srow, int sch, const u32x4 (&pr)[4], const u32x4 (&qr)[4]) {
#pragma unroll
  for (int ps = 0; ps < 4; ++ps) {
    *(u32x4*)(buf + swz128(srow + 32 * ps, sch)) = pr[ps];
    *(u32x4*)(buf + 16384 + swz128(srow + 32 * ps, sch)) = qr[ps];
  }
}
DI void gemm_compute(const char* cur, int wi, int wj, int r, int h, f32x16 (&acc)[2][2]) {
  bf16x8 a[2][2], bq[2][2];
#pragma unroll
  for (int mi = 0; mi < 2; ++mi) a[0][mi] = *(const bf16x8*)(cur + swz128(wi * 64 + mi * 32 + r, h));
#pragma unroll
  for (int nj = 0; nj < 2; ++nj) bq[0][nj] = *(const bf16x8*)(cur + 16384 + swz128(wj * 64 + nj * 32 + r, h));
#pragma unroll
  for (int kk = 0; kk < 4; ++kk) {
    if (kk < 3) {
#pragma unroll
      for (int mi = 0; mi < 2; ++mi) a[(kk + 1) & 1][mi] = *(const bf16x8*)(cur + swz128(wi * 64 + mi * 32 + r, (kk + 1) * 2 + h));
#pragma unroll
      for (int nj = 0; nj < 2; ++nj) bq[(kk + 1) & 1][nj] = *(const bf16x8*)(cur + 16384 + swz128(wj * 64 + nj * 32 + r, (kk + 1) * 2 + h));
    }
    __builtin_amdgcn_sched_barrier(0);
#pragma unroll
    for (int mi = 0; mi < 2; ++mi)
#pragma unroll
      for (int nj = 0; nj < 2; ++nj) acc[mi][nj] = MFMA32(a[kk & 1][mi], bq[kk & 1][nj], acc[mi][nj]);
    __builtin_amdgcn_sched_barrier(0);
  }
}
DI void gemm_dma(const ushort_t* __restrict__ P, const ushort_t* __restrict__ Q, int kt, char* buf, int srow, int csrc, int wid) {
#pragma unroll
  for (int ps = 0; ps < 4; ++ps) {
    const size_t go = (size_t)(srow + 32 * ps) * 1024 + kt * 64 + csrc * 8;
    __builtin_amdgcn_global_load_lds((const unsigned*)(P + go), (unsigned*)(buf + ps * 4096 + wid * 1024), 16, 0, 0);
    __builtin_amdgcn_global_load_lds((const unsigned*)(Q + go), (unsigned*)(buf + 16384 + ps * 4096 + wid * 1024), 16, 0, 0);
  }
}
DI void gemm_main(const ushort_t* __restrict__ P, const ushort_t* __restrict__ Q, char* smem, f32x16 (&acc)[2][2], const int tid) {
  const int lane = tid & 63, w = tid >> 6, wi = w >> 1, wj = w & 1;
  const int r = lane & 31, h = lane >> 5;
  const int srow = tid >> 3, csrc = (tid & 7) ^ ((srow >> 1) & 7);
  const int wid = __builtin_amdgcn_readfirstlane(w);
  gemm_dma(P, Q, 0, smem, srow, csrc, wid);
  asm volatile("s_waitcnt vmcnt(0)" ::: "memory");
  __syncthreads();
#pragma unroll 1
  for (int kt = 0; kt < 16; ++kt) {
    char* cur = smem + (kt & 1) * 32768;
    char* nxt = smem + ((kt + 1) & 1) * 32768;
    if (kt + 1 < 16) gemm_dma(P, Q, kt + 1, nxt, srow, csrc, wid);
    gemm_compute(cur, wi, wj, r, h, acc);
    asm volatile("s_waitcnt vmcnt(0)" ::: "memory");
    __syncthreads();
  }
}

DI void zero_acc(f32x16 (&acc)[2][2]) {
#pragma unroll
  for (int a = 0; a < 2; ++a)
#pragma unroll
    for (int b = 0; b < 2; ++b)
#pragma unroll
      for (int i = 0; i < 16; ++i) acc[a][b][i] = 0.f;
}

DI void phase_qkv(const Params& p, int layer, char* smem) {
  const int tid = opaque_tid(), lane = tid & 63, w = tid >> 6, wi = w >> 1, wj = w & 1;
  const int r = lane & 31, h = lane >> 5;
  const int NI = layer == 0 ? 18 : 24;
  const ushort_t* W = layer == 0 ? P_WABIN : P_WCIN;
  const int ntiles = NI * 264;
  constexpr int SST = 272;
  for (int id = blockIdx.x; id < ntiles; id += gridDim.x) {
    const int jt = id / NI, it = id - jt * NI;
    const int f0 = it * 128, t0 = jt * 128;
    const int hu0 = f0 >> 6;
    int kind, dcol0;
    const float* gain;
    if (layer == 0) {
      if (hu0 < 8) { kind = 0; dcol0 = hu0 * 64; gain = p.a_qn; }
      else if (hu0 < 10) { kind = 1; dcol0 = (hu0 - 8) * 64; gain = p.a_kn; }
      else if (hu0 < 12) { kind = 2; dcol0 = (hu0 - 10) * 64; gain = p.a_qn; }
      else if (hu0 < 20) { kind = 0; dcol0 = 512 + (hu0 - 12) * 64; gain = p.b_qn; }
      else if (hu0 < 28) { kind = 1; dcol0 = 128 + (hu0 - 20) * 64; gain = p.b_kn; }
      else { kind = 2; dcol0 = 128 + (hu0 - 28) * 64; gain = p.a_qn; }
    } else {
      if (hu0 < 16) { kind = 0; dcol0 = hu0 * 64; gain = p.c_qn; }
      else if (hu0 < 32) { kind = 1; dcol0 = (hu0 - 16) * 64; gain = p.c_kn; }
      else { kind = 2; dcol0 = (hu0 - 32) * 64; gain = p.c_qn; }
    }
    const int b = t0 / LKB;
    const int pp0 = t0 - b * LKB;
    f32x16 acc[2][2];
    zero_acc(acc);
    if (kind == 2) gemm_main(P_H + (size_t)t0 * 1024, W + (size_t)f0 * 1024, smem, acc, tid);
    else gemm_main(W + (size_t)f0 * 1024, P_H + (size_t)t0 * 1024, smem, acc, tid);
    char* stg = smem;
#pragma unroll
    for (int nj = 0; nj < 2; ++nj) {
      const int jrow = wj * 64 + nj * 32 + r;
      char* srow_p = stg + jrow * SST + (wi * 64 + 4 * h) * 2;
      if (kind == 2) {
#pragma unroll
        for (int mi = 0; mi < 2; ++mi)
#pragma unroll
          for (int g = 0; g < 4; ++g)
            *(uint2*)(srow_p + (mi * 32 + 8 * g) * 2) = make_uint2(pack2(acc[mi][nj][4 * g], acc[mi][nj][4 * g + 1]),
                                                                  pack2(acc[mi][nj][4 * g + 2], acc[mi][nj][4 * g + 3]));
      } else {
        const int pp = pp0 + jrow;
        float ss = 0.f;
#pragma unroll
        for (int mi = 0; mi < 2; ++mi)
#pragma unroll
          for (int reg = 0; reg < 16; ++reg) ss += acc[mi][nj][reg] * acc[mi][nj][reg];
        ss += __shfl_xor(ss, 32);
        const float rn = rsqrtf(ss * (1.f / 64.f) + 1e-6f);
        const float sc = (kind == 0) ? 0.125f * LOG2E : 1.f;
        const bool rope = (layer == 0) && (pp >= 256);
        const int s = pp - 256;
#pragma unroll
        for (int mi = 0; mi < 2; ++mi) {
          float v[16];
#pragma unroll
          for (int reg = 0; reg < 16; ++reg) v[reg] = acc[mi][nj][reg] * rn * gain[mi * 32 + crow(reg, h)];
          if (rope) {
            const int ps = (mi == 0) ? (s >> 6) : (s & 63);
#pragma unroll
            for (int q = 0; q < 8; ++q) {
              const float2 cs = P_ROPE[ps * 16 + crow(q, h)];
              const float x1 = v[q], x2 = v[q + 8];
              v[q] = x1 * cs.x - x2 * cs.y;
              v[q + 8] = x1 * cs.y + x2 * cs.x;
            }
          }
#pragma unroll
          for (int g = 0; g < 4; ++g)
            *(uint2*)(srow_p + (mi * 32 + 8 * g) * 2) =
                make_uint2(pack2(v[4 * g] * sc, v[4 * g + 1] * sc), pack2(v[4 * g + 2] * sc, v[4 * g + 3] * sc));
        }
      }
    }
    __syncthreads();
    ushort_t* obase;
    size_t ostride;
    if (kind == 2) { obase = P_VT + ((size_t)(b * 1024 + dcol0)) * LKB + pp0; ostride = LKB; }
    else { obase = (kind == 0 ? P_QB : P_KB) + (size_t)t0 * 1024 + dcol0; ostride = 1024; }
#pragma unroll
    for (int i = 0; i < 8; ++i) {
      const int idx = tid + 256 * i;
      const int row = idx >> 4, ch = idx & 15;
      const u32x4 val = *(const u32x4*)(stg + row * SST + ch * 16);
      *(u32x4*)(obase + (size_t)row * ostride + ch * 8) = val;
    }
    __syncthreads();
  }
}

DI void phase_outproj(const Params& p, int layer, char* smem) {
  const int tid = opaque_tid(), lane = tid & 63, w = tid >> 6, wi = w >> 1, wj = w & 1;
  const int r = lane & 31, h = lane >> 5;
  const ushort_t* W = layer == 0 ? P_WABOUT : P_WCOUT;
  const int ntok_tiles = layer == 0 ? 264 : 256;
  for (int id = blockIdx.x; id < ntok_tiles * 8; id += gridDim.x) {
    int it = id >> 3;
    const int jt = id & 7;
    if (layer == 1) it = (it >> 6) * 66 + 2 + (it & 63);
    const int i0 = it * 128, j0 = jt * 128;
    f32x16 acc[2][2];
    zero_acc(acc);
    gemm_main(P_H + (size_t)i0 * 1024, W + (size_t)j0 * 1024, smem, acc, tid);
    const int b = i0 / LKB, pp0 = i0 - b * LKB;
    const bool isctx = pp0 < 256;
    const int mr = isctx ? 4 : b;
    const float* gate = P_MOD + (layer * 5 + mr) * 6144 + 2 * 1024;
    const float* xin_base;
    if (layer == 0) xin_base = isctx ? p.ctx + ((size_t)b * 256 + pp0) * 1024 : p.x + ((size_t)b * 8192 + (pp0 - 256)) * 1024;
    else xin_base = P_R + (size_t)i0 * 1024;
    float* r_base = P_R + (size_t)i0 * 1024 + j0;
    xin_base += j0;
    unsigned lane_off = (unsigned)((wi * 64 + 4 * h) * 1024 + wj * 64 + r);
    asm volatile("" : "+v"(lane_off));
#pragma unroll
    for (int nj = 0; nj < 2; ++nj) {
      const float gt = gate[j0 + wj * 64 + nj * 32 + r];
#pragma unroll
      for (int mi = 0; mi < 2; ++mi) {
        float xin[16];
#pragma unroll
        for (int reg = 0; reg < 16; ++reg)
          xin[reg] = xin_base[lane_off + (unsigned)((mi * 32 + (reg & 3) + 8 * (reg >> 2)) * 1024 + nj * 32)];
#pragma unroll
        for (int reg = 0; reg < 16; ++reg)
          r_base[lane_off + (unsigned)((mi * 32 + (reg & 3) + 8 * (reg >> 2)) * 1024 + nj * 32)] = xin[reg] + gt * acc[mi][nj][reg];
      }
    }
  }
}

template <int NDF, int MODE>
DI bool attn_tile(const bool safe, const bool zref, const char* Ks, const char* Vs, const bf16x8 (&qf)[4], f32x16 (&O)[NDF], float& mref, float& l,
                  const bool first, int lane, int cs, const float* bias_row) {
  const int r = lane & 31, h = lane >> 5;
  const int pr = (r & ~12) | ((r & 4) << 1) | ((r & 8) >> 1);
  f32x16 S[2];
  {
    const bf16x8 a0 = *(const bf16x8*)(Ks + swz128(pr, h));
    const bf16x8 a1 = *(const bf16x8*)(Ks + swz128(32 + pr, h));
    if (zref) {
      f32x16 z;
#pragma unroll
      for (int i = 0; i < 16; ++i) z[i] = 0.f;
      S[0] = MFMA32(a0, qf[0], z);
      S[1] = MFMA32(a1, qf[0], z);
    } else {
      f32x16 z;
      const float sinit = -mref;
#pragma unroll
      for (int i = 0; i < 16; ++i) z[i] = sinit;
      S[0] = MFMA32(a0, qf[0], z);
      S[1] = MFMA32(a1, qf[0], z);
    }
  }
#pragma unroll
  for (int kk = 1; kk < 4; ++kk)
#pragma unroll
    for (int kf = 0; kf < 2; ++kf) {
      const bf16x8 a = *(const bf16x8*)(Ks + swz128(kf * 32 + pr, kk * 2 + h));
      S[kf] = MFMA32(a, qf[kk], S[kf]);
    }
  if (MODE == 1) {
    const float* brow = bias_row + 8 * h;
    const int csh = cs - 8 * h;
#pragma unroll
    for (int kf = 0; kf < 2; ++kf) {
#pragma unroll
      for (int reg = 0; reg < 16; ++reg) {
        const int kc0 = kf * 32 + 16 * (reg >> 3) + (reg & 7);
        const bool valid = (unsigned)(kc0 - csh) < 16u;
        S[kf][reg] = valid ? S[kf][reg] + brow[kc0] : -INFINITY;
      }
      __builtin_amdgcn_sched_barrier(0);
    }
  }
  bool slow = false;
  if (!safe) {
  float mx = S[0][0];
#pragma unroll
  for (int kf = 0; kf < 2; ++kf)
#pragma unroll
    for (int reg = 0; reg < 16; ++reg) mx = fmaxf(mx, S[kf][reg]);
  const bool ok = first ? (fabsf(mx) <= 20.f) : (mx <= 20.f);
  slow = !__all(ok);
  if (slow) {
    mx = fmaxf(mx, __shfl_xor(mx, 32));
    const float mnew = first ? fmaxf(mx, -64.f) : fmaxf(mx, 0.f);
    const float alpha = __builtin_amdgcn_exp2f(-mnew);
    mref += mnew;
    l *= alpha;
#pragma unroll
    for (int kf = 0; kf < 2; ++kf)
#pragma unroll
      for (int reg = 0; reg < 16; ++reg) S[kf][reg] -= mnew;
#pragma unroll
    for (int df = 0; df < NDF; ++df)
#pragma unroll
      for (int i = 0; i < 16; ++i) O[df][i] *= alpha;
  }
  }
  float rs = 0.f;
#pragma unroll
  for (int kf = 0; kf < 2; ++kf)
#pragma unroll
    for (int reg = 0; reg < 16; ++reg) {
      const float pv = __builtin_amdgcn_exp2f(S[kf][reg]);
      S[kf][reg] = pv;
      rs += pv;
    }
  l += rs;
#pragma unroll
  for (int kf = 0; kf < 2; ++kf)
#pragma unroll
    for (int s2 = 0; s2 < 2; ++s2) {
      const unsigned w0 = pack2(S[kf][8 * s2 + 0], S[kf][8 * s2 + 1]), w1 = pack2(S[kf][8 * s2 + 2], S[kf][8 * s2 + 3]);
      const unsigned w2 = pack2(S[kf][8 * s2 + 4], S[kf][8 * s2 + 5]), w3 = pack2(S[kf][8 * s2 + 6], S[kf][8 * s2 + 7]);
      const uint4 pk = make_uint4(w0, w1, w2, w3);
      const bf16x8 pb = __builtin_bit_cast(bf16x8, pk);
      const int ks = kf * 2 + s2;
#pragma unroll
      for (int df = 0; df < NDF; ++df) {
        const bf16x8 a = *(const bf16x8*)(Vs + swz128(df * 32 + r, ks * 2 + h));
        O[df] = MFMA32(a, pb, O[df]);
      }
    }
  return slow;
}
template <int NDF, int MODE>
DI void attn_tile_z(const bool safe, bool& zref, const char* Ks, const char* Vs, const bf16x8 (&qf)[4], f32x16 (&O)[NDF], float& mref, float& l,
                    const bool first, int lane, int cs, const float* bias_row) {
  const bool slow = attn_tile<NDF, MODE>(safe, zref, Ks, Vs, qf, O, mref, l, first, lane, cs, bias_row);
  if (slow) zref = __all(mref == 0.f) != 0;
}

template <int KM, int NDF>
DI void attn_stage_load(const Params& p, size_t krow_u, int kcol, size_t vt_row0, int vt_col, u32x4 (&kr)[2 * KM], u32x4 (&vr)[NDF], const int tid) {
#pragma unroll
  for (int i = 0; i < 2 * KM; ++i) {
    const int id = tid + 256 * i;
    const int row = id / (8 * KM), c = id % (8 * KM);
    kr[i] = *(const u32x4*)(P_KB + (krow_u + row) * 1024 + kcol + c * 8);
  }
#pragma unroll
  for (int i = 0; i < NDF; ++i) {
    const int id = tid + 256 * i;
    const int row = id >> 3, c = id & 7;
    vr[i] = *(const u32x4*)(P_VT + (vt_row0 + row) * LKB + vt_col + c * 8);
  }
}
template <int KM, int NDF>
DI void attn_stage_write(char* buf, const u32x4 (&kr)[2 * KM], const u32x4 (&vr)[NDF], const int tid) {
#pragma unroll
  for (int i = 0; i < 2 * KM; ++i) {
    const int id = tid + 256 * i;
    const int row = id / (8 * KM), c = id % (8 * KM);
    *(u32x4*)(buf + (c >> 3) * 8192 + swz128(row, c & 7)) = kr[i];
  }
#pragma unroll
  for (int i = 0; i < NDF; ++i) {
    const int id = tid + 256 * i;
    const int row = id >> 3, c = id & 7;
    *(u32x4*)(buf + KM * 8192 + swz128(row, c)) = vr[i];
  }
}

template <int KM, int NDF>
DI void attn_stage_dma(const Params& p, size_t krow_u, int kcol, size_t vt_row0, int vt_col, char* buf, const int tid) {
  const int lane = tid & 63, lr = lane >> 3, pc = lane & 7;
  const int wid = __builtin_amdgcn_readfirstlane(tid >> 6);
#pragma unroll
  for (int i = 0; i < 2 * KM; ++i) {
    const int pcs = i * 4 + wid, mat = pcs >> 3, prow0 = (pcs & 7) * 8;
    const int row = prow0 + lr, lc = pc ^ ((row >> 1) & 7);
    __builtin_amdgcn_global_load_lds((const unsigned*)(P_KB + (krow_u + row) * 1024 + kcol + mat * 64 + lc * 8),
                                     (unsigned*)(buf + mat * 8192 + prow0 * 128), 16, 0, 0);
  }
#pragma unroll
  for (int i = 0; i < NDF; ++i) {
    const int prow0 = (i * 4 + wid) * 8;
    const int row = prow0 + lr, lc = pc ^ ((row >> 1) & 7);
    __builtin_amdgcn_global_load_lds((const unsigned*)(P_VT + (vt_row0 + row) * LKB + vt_col + lc * 8),
                                     (unsigned*)(buf + KM * 8192 + prow0 * 128), 16, 0, 0);
  }
}

DI void load_qfrags(const ushort_t* qptr, int lane, bf16x8 (&qf)[4]) {
  const int r = lane & 31, h = lane >> 5;
#pragma unroll
  for (int kk = 0; kk < 4; ++kk) qf[kk] = *(const bf16x8*)(qptr + (size_t)r * 1024 + kk * 16 + 8 * h);
}

template <int DIFF>
DI void attn_item_l0(const Params& p, char* smem, int b, int head, int q0, int nt) {
  constexpr int KM = DIFF ? 2 : 1, NDF = DIFF ? 4 : 2;
  constexpr int BUFB = KM * 8192 + NDF * 4096;
  const int tid = opaque_tid(), lane = tid & 63, w = tid >> 6;
  const int r = lane & 31, h = lane >> 5;
  int qoff, qcol, km, kcol, vfeat;
  if (DIFF) { qoff = (w >> 1) * 32; km = w & 1; qcol = 512 + (head * 2 + km) * 64; kcol = 128 + head * 128; vfeat = 128 + head * 128; }
  else { qoff = w * 32; km = 0; qcol = head * 64; kcol = (head >> 2) * 64; vfeat = (head >> 2) * 64; }
  const size_t ub = (size_t)b * LKB;
  bf16x8 qf[4];
  load_qfrags(P_QB + (ub + q0 + qoff) * 1024 + qcol, lane, qf);
  f32x16 O[NDF];
#pragma unroll
  for (int df = 0; df < NDF; ++df)
#pragma unroll
    for (int i = 0; i < 16; ++i) O[df][i] = 0.f;
  float m = 0.f, l = 0.f;
  bool zref = true;
  const bool safe = P_SCAL[DIFF ? 2 : 1] <= 20.f;
  const size_t vt_row0 = (size_t)b * 1024 + vfeat;
  attn_stage_dma<KM, NDF>(p, ub, kcol, vt_row0, 0, smem, tid);
  asm volatile("s_waitcnt vmcnt(0)" ::: "memory");
  __syncthreads();
#pragma unroll 1
  for (int t = 0; t < nt; ++t) {
    char* cur = smem + (t & 1) * BUFB;
    char* nxt = smem + ((t + 1) & 1) * BUFB;
    if (t + 1 < nt) attn_stage_dma<KM, NDF>(p, ub + (t + 1) * 64, kcol, vt_row0, (t + 1) * 64, nxt, tid);
    attn_tile_z<NDF, 0>(safe, zref, cur + km * 8192, cur + KM * 8192, qf, O, m, l, t == 0, lane, 0, nullptr);
    asm volatile("s_waitcnt vmcnt(0)" ::: "memory");
    __syncthreads();
  }
  const float lt = l + __shfl_xor(l, 32);
  const float inv = 1.f / lt;
  const size_t uq = ub + q0 + qoff + r;
  if (!DIFF) {
    ushort_t* dst = P_H + uq * 1024 + head * 64;
#pragma unroll
    for (int df = 0; df < NDF; ++df)
#pragma unroll
      for (int g = 0; g < 4; ++g)
        *(uint2*)(dst + df * 32 + 8 * g + 4 * h) = make_uint2(pack2(O[df][4 * g] * inv, O[df][4 * g + 1] * inv),
                                                              pack2(O[df][4 * g + 2] * inv, O[df][4 * g + 3] * inv));
  } else {
    float* mg = (float*)smem;
    if (km == 1) {
#pragma unroll
      for (int df = 0; df < NDF; ++df)
#pragma unroll
        for (int i = 0; i < 16; ++i) mg[((w >> 1) * 64 + df * 16 + i) * 64 + lane] = O[df][i] * inv;
    }
    __syncthreads();
    if (km == 0) {
      const float lam = P_SCAL[0];
      float ss = 0.f;
#pragma unroll
      for (int df = 0; df < NDF; ++df)
#pragma unroll
        for (int i = 0; i < 16; ++i) {
          const float v = O[df][i] * inv - lam * mg[((w >> 1) * 64 + df * 16 + i) * 64 + lane];
          O[df][i] = v;
          ss += v * v;
        }
      ss += __shfl_xor(ss, 32);
      const float rn = rsqrtf(ss * (1.f / 128.f) + 1e-6f) * 0.8f;
      ushort_t* dst = P_H + uq * 1024 + 512 + head * 128;
#pragma unroll
      for (int df = 0; df < NDF; ++df)
#pragma unroll
        for (int g = 0; g < 4; ++g) {
          const int d = df * 32 + 8 * g + 4 * h;
          const float4 sg = *(const float4*)(p.b_subln + d);
          *(uint2*)(dst + d) = make_uint2(pack2(O[df][4 * g] * rn * sg.x, O[df][4 * g + 1] * rn * sg.y),
                                          pack2(O[df][4 * g + 2] * rn * sg.z, O[df][4 * g + 3] * rn * sg.w));
        }
    }
    __syncthreads();
  }
}

DI bool attn_tile2(const bool safe, const bool zref, const char* Ks, const char* Vs, const bf16x8 (&qf)[2][4], f32x16 (&O)[2][2], float (&mref)[2],
                   float (&l)[2], const bool first, int lane) {
  const int r = lane & 31, h = lane >> 5;
  const int pr = (r & ~12) | ((r & 4) << 1) | ((r & 8) >> 1);
  f32x16 S[2][2];
  {
    const bf16x8 a0 = *(const bf16x8*)(Ks + swz128(pr, h));
    const bf16x8 a1 = *(const bf16x8*)(Ks + swz128(32 + pr, h));
    if (zref) {
      f32x16 z;
#pragma unroll
      for (int i = 0; i < 16; ++i) z[i] = 0.f;
#pragma unroll
      for (int q = 0; q < 2; ++q) { S[q][0] = MFMA32(a0, qf[q][0], z); S[q][1] = MFMA32(a1, qf[q][0], z); }
    } else {
#pragma unroll
      for (int q = 0; q < 2; ++q) {
        f32x16 z;
        const float sinit = -mref[q];
#pragma unroll
        for (int i = 0; i < 16; ++i) z[i] = sinit;
        S[q][0] = MFMA32(a0, qf[q][0], z);
        S[q][1] = MFMA32(a1, qf[q][0], z);
      }
    }
  }
#pragma unroll
  for (int kk = 1; kk < 4; ++kk)
#pragma unroll
    for (int kf = 0; kf < 2; ++kf) {
      const bf16x8 a = *(const bf16x8*)(Ks + swz128(kf * 32 + pr, kk * 2 + h));
#pragma unroll
      for (int q = 0; q < 2; ++q) S[q][kf] = MFMA32(a, qf[q][kk], S[q][kf]);
    }
  bool slow = false;
  if (!safe) {
  float mx[2];
#pragma unroll
  for (int q = 0; q < 2; ++q) {
    mx[q] = S[q][0][0];
#pragma unroll
    for (int kf = 0; kf < 2; ++kf)
#pragma unroll
      for (int reg = 0; reg < 16; ++reg) mx[q] = fmaxf(mx[q], S[q][kf][reg]);
  }
  const bool ok = first ? (fabsf(mx[0]) <= 20.f && fabsf(mx[1]) <= 20.f) : (fmaxf(mx[0], mx[1]) <= 20.f);
  slow = !__all(ok);
  if (slow) {
#pragma unroll
    for (int q = 0; q < 2; ++q) {
      const float mxq = fmaxf(mx[q], __shfl_xor(mx[q], 32));
      const float mnew = first ? fmaxf(mxq, -64.f) : fmaxf(mxq, 0.f);
      const float alpha = __builtin_amdgcn_exp2f(-mnew);
      mref[q] += mnew;
      l[q] *= alpha;
#pragma unroll
      for (int kf = 0; kf < 2; ++kf)
#pragma unroll
        for (int reg = 0; reg < 16; ++reg) S[q][kf][reg] -= mnew;
#pragma unroll
      for (int df = 0; df < 2; ++df)
#pragma unroll
        for (int i = 0; i < 16; ++i) O[q][df][i] *= alpha;
    }
  }
  }
#pragma unroll
  for (int q = 0; q < 2; ++q) {
    float rs = 0.f;
#pragma unroll
    for (int kf = 0; kf < 2; ++kf)
#pragma unroll
      for (int reg = 0; reg < 16; ++reg) {
        const float pv = __builtin_amdgcn_exp2f(S[q][kf][reg]);
        S[q][kf][reg] = pv;
        rs += pv;
      }
    l[q] += rs;
  }
#pragma unroll
  for (int kf = 0; kf < 2; ++kf)
#pragma unroll
    for (int s2 = 0; s2 < 2; ++s2) {
      bf16x8 pb[2];
#pragma unroll
      for (int q = 0; q < 2; ++q) {
        const uint4 pk = make_uint4(pack2(S[q][kf][8 * s2 + 0], S[q][kf][8 * s2 + 1]), pack2(S[q][kf][8 * s2 + 2], S[q][kf][8 * s2 + 3]),
                                    pack2(S[q][kf][8 * s2 + 4], S[q][kf][8 * s2 + 5]), pack2(S[q][kf][8 * s2 + 6], S[q][kf][8 * s2 + 7]));
        pb[q] = __builtin_bit_cast(bf16x8, pk);
      }
      const int ks = kf * 2 + s2;
#pragma unroll
      for (int df = 0; df < 2; ++df) {
        const bf16x8 a = *(const bf16x8*)(Vs + swz128(df * 32 + r, ks * 2 + h));
#pragma unroll
        for (int q = 0; q < 2; ++q) O[q][df] = MFMA32(a, pb[q], O[q][df]);
      }
    }
  return slow;
}

DI void attn_item_gqa2(const Params& p, char* smem, int b, int head, int q0, int nt) {
  constexpr int BUFB = 16384;
  const int tid = opaque_tid(), lane = tid & 63, w = tid >> 6;
  const int r = lane & 31, h = lane >> 5;
  const int qoff = w * 64, qcol = head * 64, kcol = (head >> 2) * 64, vfeat = (head >> 2) * 64;
  const size_t ub = (size_t)b * LKB;
  bf16x8 qf[2][4];
  load_qfrags(P_QB + (ub + q0 + qoff) * 1024 + qcol, lane, qf[0]);
  load_qfrags(P_QB + (ub + q0 + qoff + 32) * 1024 + qcol, lane, qf[1]);
  f32x16 O[2][2];
#pragma unroll
  for (int q = 0; q < 2; ++q)
#pragma unroll
    for (int df = 0; df < 2; ++df)
#pragma unroll
      for (int i = 0; i < 16; ++i) O[q][df][i] = 0.f;
  float m[2] = {0.f, 0.f}, l[2] = {0.f, 0.f};
  bool zref = true;
  const bool safe = P_SCAL[1] <= 20.f;
  const size_t vt_row0 = (size_t)b * 1024 + vfeat;
  attn_stage_dma<1, 2>(p, ub, kcol, vt_row0, 0, smem, tid);
  asm volatile("s_waitcnt vmcnt(0)" ::: "memory");
  __syncthreads();
#pragma unroll 1
  for (int t = 0; t < nt; ++t) {
    char* cur = smem + (t & 1) * BUFB;
    char* nxt = smem + ((t + 1) & 1) * BUFB;
    if (t + 1 < nt) attn_stage_dma<1, 2>(p, ub + (t + 1) * 64, kcol, vt_row0, (t + 1) * 64, nxt, tid);
    const bool slow = attn_tile2(safe, zref, cur, cur + 8192, qf, O, m, l, t == 0, lane);
    if (slow) zref = __all(m[0] == 0.f && m[1] == 0.f) != 0;
    asm volatile("s_waitcnt vmcnt(0)" ::: "memory");
    __syncthreads();
  }
#pragma unroll
  for (int q = 0; q < 2; ++q) {
    const float lt = l[q] + __shfl_xor(l[q], 32);
    const float inv = 1.f / lt;
    ushort_t* dst = P_H + (ub + q0 + qoff + q * 32 + r) * 1024 + head * 64;
#pragma unroll
    for (int df = 0; df < 2; ++df)
#pragma unroll
      for (int g = 0; g < 4; ++g)
        *(uint2*)(dst + df * 32 + 8 * g + 4 * h) = make_uint2(pack2(O[q][df][4 * g] * inv, O[q][df][4 * g + 1] * inv),
                                                              pack2(O[q][df][4 * g + 2] * inv, O[q][df][4 * g + 3] * inv));
  }
}

DI void phase_attn_l0(const Params& p, char* smem) {
  const int xcd = blockIdx.x & 7, lb = blockIdx.x >> 3, nbx = gridDim.x >> 3;
  for (int it = lb; it < 132; it += nbx) {
    if (it < 128) {
      const int b = xcd >> 1, hq = (xcd & 1) * 4 + (it >> 5), qb = it & 31;
      attn_item_gqa2(p, smem, b, hq, 256 + qb * 256, 132);
    } else {
      const int b = xcd >> 1, hq = (xcd & 1) * 4 + (it - 128);
      attn_item_gqa2(p, smem, b, hq, 0, 4);
    }
  }
  for (int it = lb; it < 264; it += nbx) {
    if (it < 256) {
      const int combo = xcd * 2 + (it >> 7), qb = it & 127;
      attn_item_l0<1>(p, smem, combo >> 2, combo & 3, 256 + qb * 64, 132);
    } else {
      const int j = it - 256, combo = xcd * 2 + (j >> 2), qb = j & 3;
      attn_item_l0<1>(p, smem, combo >> 2, combo & 3, qb * 64, 4);
    }
  }
}

DI int rs_of(int row) { return min(max(row - 4, 0), 120); }
DI void phase_attn_l1(const Params& p, char* smem) {
  constexpr int BUFB = 16384;
  const int tid = opaque_tid(), lane = tid & 63, w = tid >> 6;
  const int r = lane & 31, h = lane >> 5;
  float* rpbL = (float*)(smem + 32768);
  int cur_h = -1;
  for (int it = blockIdx.x; it < 4096; it += gridDim.x) {
    const int b = it >> 10, rp = (it >> 4) & 63, hh = it & 15;
    const int r0 = rp * 2;
    const int rsA = rs_of(r0), rsB = rs_of(r0 + 1) + 7;
    const int nwin = rsB - rsA + 1, nt = nwin + 4;
    const int row = r0 + (w >> 1), qfi = w & 1;
    const int rsw = rs_of(row);
    const int j = qfi * 32 + r;
    const int cs = min(max(j - 8, 0), 48);
    const size_t ub = (size_t)b * LKB;
    if (hh != cur_h) {
      __syncthreads();
      for (int i = tid; i < 465; i += 256) rpbL[i] = p.c_rpb[hh * 465 + i] * LOG2E;
      cur_h = hh;
    }
    bf16x8 qf[4];
    load_qfrags(P_QB + (ub + 256 + row * 64 + qfi * 32) * 1024 + hh * 64, lane, qf);
    f32x16 O[2];
#pragma unroll
    for (int df = 0; df < 2; ++df)
#pragma unroll
      for (int i = 0; i < 16; ++i) O[df][i] = 0.f;
    float m = 0.f, l = 0.f;
    bool zref = true;
    const bool safe = P_SCAL[3] <= 20.f;
    const size_t vt_row0 = (size_t)b * 1024 + hh * 64;
    {
      const int kp = 256 + rsA * 64;
      attn_stage_dma<1, 2>(p, ub + kp, hh * 64, vt_row0, kp, smem, tid);
    }
    asm volatile("s_waitcnt vmcnt(0)" ::: "memory");
    __syncthreads();
#pragma unroll 1
    for (int t = 0; t < nt; ++t) {
      char* cur = smem + (t & 1) * BUFB;
      char* nxt = smem + ((t + 1) & 1) * BUFB;
      if (t + 1 < nt) {
        const int kp = (t + 1 < nwin) ? 256 + (rsA + t + 1) * 64 : (t + 1 - nwin) * 64;
        attn_stage_dma<1, 2>(p, ub + kp, hh * 64, vt_row0, kp, nxt, tid);
      }
      if (t < nwin) {
        const int krw = rsA + t;
        const bool inband = (krw >= rsw) && (krw <= rsw + 7);
        attn_tile_z<2, 1>(safe, zref, cur, cur + 8192, qf, O, m, l, krw == rsw, lane, inband ? cs : 1000, rpbL + (krw - row + 7) * 31 + 15 - j);
      } else {
        attn_tile_z<2, 0>(safe, zref, cur, cur + 8192, qf, O, m, l, false, lane, 0, nullptr);
      }
      asm volatile("s_waitcnt vmcnt(0)" ::: "memory");
      __syncthreads();
    }
    const float lt = l + __shfl_xor(l, 32);
    const float inv = 1.f / lt;
    ushort_t* dst = P_H + (ub + 256 + row * 64 + j) * 1024 + hh * 64;
#pragma unroll
    for (int df = 0; df < 2; ++df)
#pragma unroll
      for (int g = 0; g < 4; ++g)
        *(uint2*)(dst + df * 32 + 8 * g + 4 * h) = make_uint2(pack2(O[df][4 * g] * inv, O[df][4 * g + 1] * inv),
                                                              pack2(O[df][4 * g + 2] * inv, O[df][4 * g + 3] * inv));
  }
}

DI void phase_peerq(const Params& p, int layer, char* smem) {
  const int tid = opaque_tid(), lane = tid & 63, w = tid >> 6, wi_ = w >> 1, wj_ = w & 1;
  const int r_ = lane & 31, h_ = lane >> 5;
  const int ntok_tiles = layer == 0 ? 264 : 256;
  for (int id = blockIdx.x; id < ntok_tiles * 16; id += gridDim.x) {
    int jt = id >> 4;
    const int it = id & 15;
    if (layer == 1) jt = (jt >> 6) * 66 + 2 + (jt & 63);
    const int j0 = jt * 128;
    f32x16 acc[2][2];
    zero_acc(acc);
    gemm_main(P_WPQ + ((size_t)layer * 2048 + it * 128) * 1024, P_H + (size_t)j0 * 1024, smem, acc, tid);
    char* pqs = smem;
    char* kss = smem + 32768;
    int r = r_, h = h_, wi = wi_, wj = wj_;
    asm volatile("" : "+v"(r), "+v"(h), "+v"(wi), "+v"(wj));
#pragma unroll
    for (int nj = 0; nj < 2; ++nj) {
      const int tok = wj * 64 + nj * 32 + r;
#pragma unroll
      for (int mi = 0; mi < 2; ++mi)
#pragma unroll
        for (int g = 0; g < 4; ++g) {
          const int d = wi * 64 + mi * 32 + 8 * g + 4 * h;
          *(uint2*)(pqs + swz256(tok, d >> 3) + (d & 7) * 2) =
              make_uint2(pack2(acc[mi][nj][4 * g], acc[mi][nj][4 * g + 1]), pack2(acc[mi][nj][4 * g + 2], acc[mi][nj][4 * g + 3]));
        }
    }
    const ushort_t* kg = P_KEYS + ((size_t)layer * 16 + it) * 128 * 128;
#pragma unroll
    for (int i = 0; i < 8; ++i) {
      const int idc = tid + 256 * i;
      const int row = idc >> 4, c = idc & 15;
      *(uint4*)(kss + swz256(row, c)) = *(const uint4*)(kg + row * 128 + c * 8);
    }
    __syncthreads();
    zero_acc(acc);
#pragma unroll
    for (int kk = 0; kk < 8; ++kk) {
      bf16x8 a[2], bq[2];
#pragma unroll
      for (int mi = 0; mi < 2; ++mi) a[mi] = *(const bf16x8*)(kss + swz256(wi * 64 + mi * 32 + r, kk * 2 + h));
#pragma unroll
      for (int nj = 0; nj < 2; ++nj) bq[nj] = *(const bf16x8*)(pqs + swz256(wj * 64 + nj * 32 + r, kk * 2 + h));
#pragma unroll
      for (int mi = 0; mi < 2; ++mi)
#pragma unroll
        for (int nj = 0; nj < 2; ++nj) acc[mi][nj] = MFMA32(a[mi], bq[nj], acc[mi][nj]);
    }
    __syncthreads();
    float* sc = (float*)smem;
#pragma unroll
    for (int mi = 0; mi < 2; ++mi)
#pragma unroll
      for (int nj = 0; nj < 2; ++nj)
#pragma unroll
        for (int reg = 0; reg < 16; ++reg)
          sc[(wi * 64 + mi * 32 + crow(reg, h)) * 128 + wj * 64 + nj * 32 + r] = acc[mi][nj][reg];
    __syncthreads();
    const int tok = tid & 127, half = tid >> 7;
    float v[16];
#pragma unroll
    for (int k = 0; k < 16; ++k) v[k] = -INFINITY;
    for (int n = half * 64; n < half * 64 + 64; ++n) {
      float xk = __uint_as_float((__float_as_uint(sc[n * 128 + tok]) & ~127u) | (unsigned)n);
#pragma unroll
      for (int k = 0; k < 16; ++k) {
        const float hi = fmaxf(v[k], xk);
        xk = fminf(v[k], xk);
        v[k] = hi;
      }
    }
    __syncthreads();
    if (half == 1) {
#pragma unroll
      for (int k = 0; k < 16; ++k) sc[k * 128 + tok] = v[k];
    }
    __syncthreads();
    if (half == 0) {
#pragma unroll
      for (int q = 0; q < 16; ++q) {
        float xk = sc[q * 128 + tok];
#pragma unroll
        for (int k = 0; k < 16; ++k) {
          const float hi = fmaxf(v[k], xk);
          xk = fminf(v[k], xk);
          v[k] = hi;
        }
      }
      unsigned* dst = P_TOPK + ((size_t)(j0 + tok) * 16 + it) * 16;
#pragma unroll
      for (int q = 0; q < 4; ++q)
        *(uint4*)(dst + 4 * q) = make_uint4(__float_as_uint(v[4 * q]), __float_as_uint(v[4 * q + 1]), __float_as_uint(v[4 * q + 2]),
                                            __float_as_uint(v[4 * q + 3]));
    }
    __syncthreads();
  }
}

DI float gelu_fast(float x) {
  const float z = 0.7978845608028654f * (x + 0.044715f * x * x * x);
  return x * __builtin_amdgcn_rcpf(1.f + exp2f(-2.f * LOG2E * z));
}
DI float gelu_tanh(float x) { return 0.5f * x * (1.f + tanhf(0.7978845608028654f * (x + 0.044715f * x * x * x))); }

DI void peer_batch_load(const Params& p, const int* se, const float* sg, int eb, int lane, u32x4 (&ur)[8], u32x2 (&vr)[8],
                        float& uis_my, float& vis_my, float& g_my) {
  const int myq = eb * 8 + (lane >> 3);
  const int e_my = se[myq];
  g_my = sg[myq];
  uis_my = P_UIS[e_my];
  vis_my = P_VIS[e_my];
#pragma unroll
  for (int q = 0; q < 8; ++q) {
    const int ei = __builtin_amdgcn_readfirstlane(se[eb * 8 + q]);
    ur[q] = *(const u32x4*)(P_U8 + (size_t)ei * 1024 + lane * 16);
    vr[q] = *(const u32x2*)(P_V8 + (size_t)ei * 512 + lane * 8);
  }
}
DI void peer_batch_compute(const u32x4 (&ur)[8], const u32x2 (&vr)[8], float uscale, float vis_my, float g_my, const int (&xq)[4],
                           f32x2 (&yv)[8], int lane) {
  const bool b5 = (lane & 32) != 0, b4 = (lane & 16) != 0, b3 = (lane & 8) != 0;
  float d[8];
#pragma unroll
  for (int q = 0; q < 8; ++q) {
    int a = 0;
#pragma unroll
    for (int k = 0; k < 4; ++k) a = __builtin_amdgcn_sdot4((int)ur[q][k], xq[k], a, false);
    d[q] = (float)a;
  }
  float t4[4], t2[2], t1;
#pragma unroll
  for (int i = 0; i < 4; ++i) {
    const float snd = b5 ? d[i] : d[i + 4], kp = b5 ? d[i + 4] : d[i];
    t4[i] = kp + __shfl_xor(snd, 32);
  }
#pragma unroll
  for (int i = 0; i < 2; ++i) {
    const float snd = b4 ? t4[i] : t4[i + 2], kp = b4 ? t4[i + 2] : t4[i];
    t2[i] = kp + __shfl_xor(snd, 16);
  }
  {
    const float snd = b3 ? t2[0] : t2[1], kp = b3 ? t2[1] : t2[0];
    t1 = kp + dpp_f<0x140>(snd);
  }
  t1 += dpp_f<0x141>(t1);
  t1 += dpp_f<0x4E>(t1);
  t1 += dpp_f<0xB1>(t1);
  const float wmy = g_my * gelu_fast(t1 * uscale) * vis_my;
#pragma unroll
  for (int q = 0; q < 8; ++q) {
    const float wq = __builtin_bit_cast(float, __builtin_amdgcn_readlane(__builtin_bit_cast(int, wmy), 8 * q));
    const f32x2 w2 = {wq, wq};
#pragma unroll
    for (int k = 0; k < 2; ++k) {
      yv[4 * k + 0] += w2 * __builtin_amdgcn_cvt_scalef32_pk_f32_fp4(vr[q][k], 1.0f, 0);
      yv[4 * k + 1] += w2 * __builtin_amdgcn_cvt_scalef32_pk_f32_fp4(vr[q][k], 1.0f, 1);
      yv[4 * k + 2] += w2 * __builtin_amdgcn_cvt_scalef32_pk_f32_fp4(vr[q][k], 1.0f, 2);
      yv[4 * k + 3] += w2 * __builtin_amdgcn_cvt_scalef32_pk_f32_fp4(vr[q][k], 1.0f, 3);
    }
  }
}

DI void phase_peer_final(const Params& p, int layer, char* smem) {
  const int tid = opaque_tid(), lane = tid & 63, w = tid >> 6;
  const int wave = (blockIdx.x * 256 + tid) >> 6, nw = gridDim.x * 4;
  int* se = (int*)(smem + w * 2048);
  float* sg = (float*)(smem + w * 2048 + 512);
  float* sr = (float*)(smem + w * 2048 + 1024);
  int ci, cj;
  if (lane < 16) { ci = 0; cj = lane; }
  else if (lane < 24) { ci = 1; cj = lane - 16; }
  else if (lane < 29) { ci = 2; cj = lane - 24; }
  else if (lane < 33) { ci = 3; cj = lane - 29; }
  else if (lane < 36) { ci = 4; cj = lane - 33; }
  else if (lane < 42) { ci = 5 + ((lane - 36) >> 1); cj = (lane - 36) & 1; }
  else if (lane < 50) { ci = 8 + (lane - 42); cj = 0; }
  else { ci = 0; cj = 0; }
  const int ntok = (layer == 0) ? NTOK : 4 * 8192;
  u32x4 cx0, cx1;
  unsigned ck1[8], ck2[8];
  {
    const int idx0 = min(wave, ntok - 1);
    const int u0 = (layer == 0) ? idx0 : (idx0 >> 13) * LKB + 256 + (idx0 & 8191);
    cx0 = *(const u32x4*)(P_H + (size_t)u0 * 1024 + lane * 16);
    cx1 = *(const u32x4*)(P_H + (size_t)u0 * 1024 + lane * 16 + 8);
#pragma unroll
    for (int hd = 0; hd < 8; ++hd) {
      const unsigned* tk = P_TOPK + ((size_t)u0 * 8 + hd) * 32;
      ck1[hd] = tk[ci];
      ck2[hd] = tk[16 + cj];
    }
  }
  for (int idx = wave; idx < ntok; idx += nw) {
    const int u = (layer == 0) ? idx : (idx >> 13) * LKB + 256 + (idx & 8191);
    const int b = u / LKB, pp = u - b * LKB;
    const bool isctx = pp < 256;
    float xf[16];
    {
      xf[0] = bf_lo(cx0.x); xf[1] = bf_hi(cx0.x); xf[2] = bf_lo(cx0.y); xf[3] = bf_hi(cx0.y);
      xf[4] = bf_lo(cx0.z); xf[5] = bf_hi(cx0.z); xf[6] = bf_lo(cx0.w); xf[7] = bf_hi(cx0.w);
      xf[8] = bf_lo(cx1.x); xf[9] = bf_hi(cx1.x); xf[10] = bf_lo(cx1.y); xf[11] = bf_hi(cx1.y);
      xf[12] = bf_lo(cx1.z); xf[13] = bf_hi(cx1.z); xf[14] = bf_lo(cx1.w); xf[15] = bf_hi(cx1.w);
    }
    float xmx = 0.f;
#pragma unroll
    for (int i = 0; i < 16; ++i) xmx = fmaxf(xmx, fabsf(xf[i]));
    xmx = wave_max(xmx);
    const float xsc = (xmx > 1e-30f) ? 127.f / xmx : 1.f;
    const float x_inv = (xmx > 1e-30f) ? xmx * (1.f / 127.f) : 1.f;
    int xq[4];
#pragma unroll
    for (int k = 0; k < 4; ++k)
      xq[k] = (int)(((unsigned)__float2int_rn(xf[4 * k] * xsc) & 255u) | (((unsigned)__float2int_rn(xf[4 * k + 1] * xsc) & 255u) << 8) |
                    (((unsigned)__float2int_rn(xf[4 * k + 2] * xsc) & 255u) << 16) | (((unsigned)__float2int_rn(xf[4 * k + 3] * xsc) & 255u) << 24));
    unsigned* sru = (unsigned*)sr;
#pragma unroll
    for (int hd = 0; hd < 8; ++hd) {
      const unsigned k1 = ck1[hd], k2 = ck2[hd];
      const float s = __uint_as_float(k1) + __uint_as_float(k2);
      const int e = (int)((k1 & 127u) * 128u + (k2 & 127u));
      unsigned ob = __float_as_uint(s);
      ob ^= (ob & 0x80000000u) ? 0xffffffffu : 0x80000000u;
      const unsigned key = (lane < 50) ? ((ob & ~63u) | (unsigned)(63 - lane)) : 0u;
      sru[lane] = key;
      __builtin_amdgcn_wave_barrier();
      int rank = 0;
#pragma unroll
      for (int L4 = 0; L4 < 13; ++L4) {
        const u32x4 q4 = *(const u32x4*)(sru + 4 * L4);
        rank += (q4.x > key) ? 1 : 0;
        rank += (q4.y > key) ? 1 : 0;
        rank += (q4.z > key) ? 1 : 0;
        rank += (q4.w > key) ? 1 : 0;
      }
      __builtin_amdgcn_wave_barrier();
      if ((lane < 50) && (rank < 16)) { se[hd * 16 + rank] = e; sg[hd * 16 + rank] = s; }
    }
    __builtin_amdgcn_wave_barrier();
#pragma unroll
    for (int j = 0; j < 2; ++j) {
      const int idx = lane + 64 * j;
      const float sv = sg[idx], m0 = sg[idx & ~15];
      const float ex = exp2f((sv - m0) * LOG2E);
      float sm = ex;
      sm += __shfl_xor(sm, 1); sm += __shfl_xor(sm, 2); sm += __shfl_xor(sm, 4); sm += __shfl_xor(sm, 8);
      __builtin_amdgcn_wave_barrier();
      sg[idx] = ex * __builtin_amdgcn_rcpf(sm);
    }
    __builtin_amdgcn_wave_barrier();
    f32x2 xv[8], yv[8];
#pragma unroll
    for (int i = 0; i < 8; ++i) { xv[i].x = xf[2 * i]; xv[i].y = xf[2 * i + 1]; yv[i].x = 0.f; yv[i].y = 0.f; }
    const bool b5 = (lane & 32) != 0, b4 = (lane & 16) != 0, b3 = (lane & 8) != 0;
    {
      const int idxn = min(idx + nw, ntok - 1);
      const int un = (layer == 0) ? idxn : (idxn >> 13) * LKB + 256 + (idxn & 8191);
      cx0 = *(const u32x4*)(P_H + (size_t)un * 1024 + lane * 16);
      cx1 = *(const u32x4*)(P_H + (size_t)un * 1024 + lane * 16 + 8);
#pragma unroll
      for (int hd = 0; hd < 8; ++hd) {
        const unsigned* tk = P_TOPK + ((size_t)un * 8 + hd) * 32;
        ck1[hd] = tk[ci];
        ck2[hd] = tk[16 + cj];
      }
    }
    const int mr = isctx ? 4 : b;
    const float* gate = P_MOD + (layer * 5 + mr) * 6144 + 5 * 1024;
    const float* rsrc = P_R + (size_t)u * 1024;
    float4 rv4[4], gv4[4];
#pragma unroll
    for (int q = 0; q < 4; ++q) {
      rv4[q] = *(const float4*)(rsrc + lane * 16 + q * 4);
      gv4[q] = *(const float4*)(gate + lane * 16 + q * 4);
    }
    {
      u32x4 urA[8], urB[8];
      u32x2 vrA[8], vrB[8];
      float sA, vA, gA, sB, vB, gB;
      peer_batch_load(p, se, sg, 0, lane, urA, vrA, sA, vA, gA);
#pragma unroll 1
      for (int eb = 0; eb < 16; eb += 2) {
        peer_batch_load(p, se, sg, eb + 1, lane, urB, vrB, sB, vB, gB);
        __builtin_amdgcn_sched_barrier(0);
        peer_batch_compute(urA, vrA, sA * x_inv, vA, gA, xq, yv, lane);
        peer_batch_load(p, se, sg, min(eb + 2, 15), lane, urA, vrA, sA, vA, gA);
        __builtin_amdgcn_sched_barrier(0);
        peer_batch_compute(urB, vrB, sB * x_inv, vB, gB, xq, yv, lane);
      }
    }
    float y[16];
#pragma unroll
    for (int i = 0; i < 8; ++i) { y[2 * i] = yv[i].x; y[2 * i + 1] = yv[i].y; }
    __builtin_amdgcn_wave_barrier();
    float* dst = (layer == 0) ? P_R + (size_t)u * 1024 : p.out + ((size_t)b * 8192 + (pp - 256)) * 1024;
    float4 ov[4];
    float ss = 0.f;
#pragma unroll
    for (int q = 0; q < 4; ++q) {
      const int col = lane * 16 + q * 4;
      const float4 rv = rv4[q];
      const float4 gv = gv4[q];
      float4 o;
      o.x = rv.x + gv.x * y[q * 4 + 0];
      o.y = rv.y + gv.y * y[q * 4 + 1];
      o.z = rv.z + gv.z * y[q * 4 + 2];
      o.w = rv.w + gv.w * y[q * 4 + 3];
      *(float4*)(dst + col) = o;
      ov[q] = o;
      ss += o.x * o.x + o.y * o.y + o.z * o.z + o.w * o.w;
    }
    if (layer == 0) {
      ss = wave_sum(ss);
      const float rn = rsqrtf(ss * (1.f / 1024.f) + 1e-6f);
      const float* g1 = p.norm_g + 2 * 1024;
      const float* shift = P_MOD + (5 + mr) * 6144;
      const float* scale = shift + 1024;
#pragma unroll
      for (int q = 0; q < 4; ++q) {
        const int col = lane * 16 + q * 4;
        const float4 g4 = *(const float4*)(g1 + col), sc = *(const float4*)(scale + col), sh = *(const float4*)(shift + col);
        const float y0 = ov[q].x * rn * g4.x * (1.f + sc.x) + sh.x;
        const float y1 = ov[q].y * rn * g4.y * (1.f + sc.y) + sh.y;
        const float y2 = ov[q].z * rn * g4.z * (1.f + sc.z) + sh.z;
        const float y3 = ov[q].w * rn * g4.w * (1.f + sc.w) + sh.w;
        *(uint2*)(P_H + (size_t)u * 1024 + col) = make_uint2(pack2(y0, y1), pack2(y2, y3));
      }
    }
  }
}

__global__ void __launch_bounds__(256, 2) fwd_mega(Params p) {
  cg::grid_group grid = cg::this_grid();
  __shared__ __attribute__((aligned(16))) char smem[SMEM_BYTES];
  volatile LAS unsigned* xb_st = (volatile LAS unsigned*)(smem + SMEM_BYTES - 16);
  if (threadIdx.x == 0) { xb_st[0] = 0u; xb_st[1] = 0u; }
  __syncthreads();
  const XcdBarrier xb = xcd_barrier_post(P_BAR, xb_st);
  phase_prologue(p, smem);
  xcd_barrier(xb);
  if (p.out == nullptr) grid.sync();
  for (int layer = 0; layer < 2; ++layer) {
    if (layer == 0) {
      phase_norm(p, 0, 0);
      xcd_barrier(xb);
    }
    phase_qkv(p, layer, smem);
    xcd_barrier(xb);
    if (layer == 0) phase_attn_l0(p, smem); else phase_attn_l1(p, smem);
    xcd_barrier(xb);
    phase_outproj(p, layer, smem);
    convert_i8_rows(p.peer_u + (size_t)layer * 16384 * 1024, P_U8, P_UIS);
    convert_fp4_rows(p.peer_v + (size_t)layer * 16384 * 1024, P_V8, P_VIS);
    xcd_barrier(xb);
    phase_norm(p, layer, 1);
    xcd_barrier(xb);
    phase_peerq(p, layer, smem);
    xcd_barrier(xb);
    phase_peer_final(p, layer, smem);
    if (layer == 0) xcd_barrier(xb);
  }
}

extern "C" void kernel_launch(void* const* d_in, const int* in_sizes, int n_in, void* d_out, int out_size, void* d_ws,
                              size_t ws_size, hipStream_t stream) {
  static int grid_blocks = 0;
  if (!grid_blocks) {
    int dev = 0, cus = 0, per_cu = 0;
    (void)hipGetDevice(&dev);
    (void)hipDeviceGetAttribute(&cus, hipDeviceAttributeMultiprocessorCount, dev);
    (void)hipOccupancyMaxActiveBlocksPerMultiprocessor(&per_cu, fwd_mega, 256, 0);
    if (per_cu > 2) per_cu = 2;
    if (per_cu < 1) per_cu = 1;
    grid_blocks = cus * per_cu;
    grid_blocks &= ~7;
  }
  Params p{};
  const float* const* in = (const float* const*)d_in;
  p.x = in[0]; p.c = in[1]; p.ctx = in[2]; p.c_ctx = in[3]; p.ada_w = in[4]; p.ada_b = in[5]; p.norm_g = in[6];
  p.ab_w_in = in[7]; p.ab_w_out = in[8]; p.a_qn = in[9]; p.a_kn = in[10]; p.b_qn = in[11]; p.b_kn = in[12]; p.b_lam = in[13];
  p.b_subln = in[14]; p.c_w_in = in[15]; p.c_w_out = in[16]; p.c_qn = in[17]; p.c_kn = in[18]; p.c_rpb = in[19];
  p.peer_wq = in[20]; p.peer_keys = in[21]; p.peer_u = in[22]; p.peer_v = in[23];
  p.out = (float*)d_out;
  p.ws = (char*)d_ws;
  if (WS_TOTAL > ws_size) { fprintf(stderr, "workspace too small: need %zu have %zu\n", (size_t)WS_TOTAL, ws_size); return; }
  (void)hipMemsetAsync((char*)d_ws + OFF_BAR, 0, 16384, stream);
  void* args[] = {&p};
  hipError_t e = hipLaunchCooperativeKernel((void*)fwd_mega, dim3(grid_blocks), dim3(256), args, 0, stream);
  if (e != hipSuccess) fprintf(stderr, "cooperative launch failed: %s (grid %d)\n", hipGetErrorString(e), grid_blocks);
}
```

```cpp
#include <hip/hip_runtime.h>
#include <hip/hip_cooperative_groups.h>
#include <cstdio>
namespace cg = cooperative_groups;

#define DI __device__ __forceinline__
typedef unsigned short ushort_t;
using bf16x8 = __attribute__((ext_vector_type(8))) short;
using f32x16 = __attribute__((ext_vector_type(16))) float;
using u32x4 = __attribute__((ext_vector_type(4))) unsigned;
using f32x2 = __attribute__((ext_vector_type(2))) float;
using u32x2 = __attribute__((ext_vector_type(2))) unsigned;
#define MFMA32(a, b, c) __builtin_amdgcn_mfma_f32_32x32x16_bf16((a), (b), (c), 0, 0, 0)

constexpr int DM = 1024;
constexpr int LKB = 8448;
constexpr int NTOK = 4 * LKB;
constexpr int SMEM_BYTES = 66560;
constexpr float LOG2E = 1.4426950408889634f;

struct Params {
  const float *x, *c, *ctx, *c_ctx, *ada_w, *ada_b, *norm_g, *ab_w_in, *ab_w_out, *a_qn, *a_kn, *b_qn, *b_kn, *b_lam,
      *b_subln, *c_w_in, *c_w_out, *c_qn, *c_kn, *c_rpb, *peer_wq, *peer_keys, *peer_u, *peer_v;
  float* out;
  char* ws;
};
constexpr size_t al256(size_t x) { return (x + 255) & ~(size_t)255; }
constexpr size_t OFF_MOD = 0;
constexpr size_t OFF_SCAL = OFF_MOD + al256(2 * 5 * 6144 * 4);
constexpr size_t OFF_BAR = OFF_SCAL + 256;
constexpr size_t OFF_ROPE = OFF_BAR + 16384;
constexpr size_t OFF_WABIN = OFF_ROPE + al256(128 * 16 * 8);
constexpr size_t OFF_WABOUT = OFF_WABIN + (size_t)2304 * 1024 * 2;
constexpr size_t OFF_WCIN = OFF_WABOUT + (size_t)1024 * 1024 * 2;
constexpr size_t OFF_WCOUT = OFF_WCIN + (size_t)3072 * 1024 * 2;
constexpr size_t OFF_WPQ = OFF_WCOUT + (size_t)1024 * 1024 * 2;
constexpr size_t OFF_KEYS = OFF_WPQ + (size_t)2 * 2048 * 1024 * 2;
constexpr size_t OFF_H = OFF_KEYS + (size_t)2 * 8 * 2 * 128 * 128 * 2;
constexpr size_t OFF_QB = OFF_H + (size_t)NTOK * 1024 * 2;
constexpr size_t OFF_KB = OFF_QB + (size_t)NTOK * 1024 * 2;
constexpr size_t OFF_VT = OFF_KB + (size_t)NTOK * 1024 * 2;
constexpr size_t OFF_R = OFF_VT + (size_t)NTOK * 1024 * 2;
constexpr size_t WS_TOTAL = OFF_R + (size_t)NTOK * 1024 * 4;
#define P_MOD ((float*)(p.ws + OFF_MOD))
#define P_SCAL ((float*)(p.ws + OFF_SCAL))
#define P_ROPE ((float2*)(p.ws + OFF_ROPE))
#define P_WABIN ((ushort_t*)(p.ws + OFF_WABIN))
#define P_WABOUT ((ushort_t*)(p.ws + OFF_WABOUT))
#define P_WCIN ((ushort_t*)(p.ws + OFF_WCIN))
#define P_WCOUT ((ushort_t*)(p.ws + OFF_WCOUT))
#define P_WPQ ((ushort_t*)(p.ws + OFF_WPQ))
#define P_KEYS ((ushort_t*)(p.ws + OFF_KEYS))
#define P_H ((ushort_t*)(p.ws + OFF_H))
#define P_QB ((ushort_t*)(p.ws + OFF_QB))
#define P_KB ((ushort_t*)(p.ws + OFF_KB))
#define P_VT ((ushort_t*)(p.ws + OFF_VT))
#define P_R ((float*)(p.ws + OFF_R))
#define P_U8 ((unsigned char*)(p.ws + OFF_QB))
#define P_V8 ((unsigned char*)(p.ws + OFF_QB) + (size_t)16384 * 1024)
#define P_UIS ((float*)(p.ws + OFF_QB + (size_t)2 * 16384 * 1024))
#define P_VIS ((float*)(p.ws + OFF_QB + (size_t)2 * 16384 * 1024 + 65536))
#define P_BAR ((unsigned*)(p.ws + OFF_BAR))
#define P_TOPK ((unsigned*)(p.ws + OFF_KB))

DI int opaque_tid() { int t = threadIdx.x; asm volatile("" : "+v"(t)); return t; }
DI float bf_lo(unsigned u) { return __uint_as_float(u << 16); }
DI float bf_hi(unsigned u) { return __uint_as_float(u & 0xffff0000u); }
DI unsigned pack2(float a, float b) {
  typedef __bf16 bf2_t __attribute__((ext_vector_type(2)));
  typedef float f2_t __attribute__((ext_vector_type(2)));
  f2_t v = {a, b};
  bf2_t r = __builtin_convertvector(v, bf2_t);
  return __builtin_bit_cast(unsigned, r);
}
DI ushort_t tobf(float a) { return (ushort_t)(pack2(a, 0.f) & 0xffffu); }
DI int crow(int reg, int h) { return (reg & 3) + 8 * (reg >> 2) + 4 * h; }
DI int swz128(int row, int chunk) { return row * 128 + ((chunk ^ ((row >> 1) & 7)) << 4); }
DI int swz256(int row, int chunk) { return row * 256 + ((chunk ^ (row & 15)) << 4); }
template <int CTRL>
DI float dpp_f(float v) {
  return __builtin_bit_cast(float, __builtin_amdgcn_update_dpp(0, __builtin_bit_cast(int, v), CTRL, 0xf, 0xf, false));
}
DI float wave_sum(float v) {
#pragma unroll
  for (int o = 32; o >= 1; o >>= 1) v += __shfl_xor(v, o);
  return v;
}
DI float wave_max(float v) {
#pragma unroll
  for (int o = 32; o >= 1; o >>= 1) v = fmaxf(v, __shfl_xor(v, o));
  return v;
}

#define XB_TMO      128
#define XB_XCNT(j)  (256  + 64 * (j))
#define XB_XSUB(j)  (1280 + 64 * (j))
#define XB_XGEN(j)  (2304 + 64 * (j))
#define XB_TOP      3328
#define XB_TOPGEN   3392
#define XCD_BAR_WORDS 3456
#define XB_SPIN_CAP (1u << 22)
#define LAS __attribute__((address_space(3)))
DI unsigned xb_ld(unsigned* p) { return __hip_atomic_load(p, __ATOMIC_RELAXED, __HIP_MEMORY_SCOPE_AGENT); }
DI unsigned xb_add(unsigned* p, unsigned v) { return __hip_atomic_fetch_add(p, v, __ATOMIC_RELAXED, __HIP_MEMORY_SCOPE_AGENT); }
DI unsigned xb_xcc_id() { return (unsigned)__builtin_amdgcn_s_getreg((3 << 11) | 20) & 0xFu; }
#define XB_SPIN(cond, bar) do { unsigned _sp = 0; while (cond) { __builtin_amdgcn_s_sleep(1); \
    if ((++_sp & 255u) == 0u) { if (xb_ld(&(bar)[XB_TMO])) break; if (_sp > XB_SPIN_CAP) { atomicAdd(&(bar)[XB_TMO], 1u); break; } } } } while (0)
struct XcdBarrier { unsigned* bar; unsigned x; volatile LAS unsigned* st; };
DI XcdBarrier xcd_barrier_post(unsigned* bar, volatile LAS unsigned* st) {
  XcdBarrier b; b.bar = bar; b.x = xb_xcc_id(); b.st = st;
  if (threadIdx.x == 0) (void)xb_add(&bar[XB_XCNT(b.x)], 1u);
  return b;
}
DI void xcd_barrier_complete(unsigned* bar, unsigned x, unsigned& nloc, unsigned& nx) {
  const unsigned G = gridDim.x;
  unsigned sum, cnt, mine, sp = 0u;
  for (;;) {
    sum = 0u; cnt = 0u; mine = 0u;
#pragma unroll
    for (unsigned j = 0; j < 16; ++j) { const unsigned c = xb_ld(&bar[XB_XCNT(j)]); sum += c; cnt += (c > 0u) ? 1u : 0u; mine = (j == x) ? c : mine; }
    if (sum == G) break;
    __builtin_amdgcn_s_sleep(1);
    if ((++sp & 255u) == 0u) { if (xb_ld(&bar[XB_TMO])) break; if (sp > XB_SPIN_CAP) { atomicAdd(&bar[XB_TMO], 1u); break; } }
  }
  nloc = mine > 0u ? mine : 1u; nx = cnt > 0u ? cnt : 1u;
}
DI void xcd_barrier(const XcdBarrier& b) {
  asm volatile("s_waitcnt vmcnt(0)" ::: "memory");
  __syncthreads();
  if (threadIdx.x == 0) {
    unsigned* bar = b.bar;
    __builtin_amdgcn_s_waitcnt(0);
    unsigned nloc = b.st[0], nx = b.st[1];
    if (nloc == 0u) { xcd_barrier_complete(bar, b.x, nloc, nx); b.st[0] = nloc; b.st[1] = nx; }
    const unsigned old = xb_add(&bar[XB_XSUB(b.x)], 1u);
    const unsigned gen = old / nloc;
    if (old + 1u == (gen + 1u) * nloc) {
      __builtin_amdgcn_fence(__ATOMIC_RELEASE, "agent");
      asm volatile("s_waitcnt vmcnt(0)" ::: "memory");
      const unsigned og = xb_add(&bar[XB_TOP], 1u);
      const unsigned tg = og / nx;
      if (og + 1u == (tg + 1u) * nx) xb_add(&bar[XB_TOPGEN], 1u);
      else XB_SPIN(xb_ld(&bar[XB_TOPGEN]) == tg, bar);
      __builtin_amdgcn_fence(__ATOMIC_ACQUIRE, "agent");
      xb_add(&bar[XB_XGEN(b.x)], 1u);
      asm volatile("s_waitcnt vmcnt(0)" ::: "memory");
    } else {
      XB_SPIN(xb_ld(&bar[XB_XGEN(b.x)]) == gen, bar);
      __builtin_amdgcn_fence(__ATOMIC_ACQUIRE, "agent");
      asm volatile("s_waitcnt vmcnt(0)" ::: "memory");
    }
  }
  __syncthreads();
}

DI void convert_i8_rows(const float* __restrict__ src, unsigned char* __restrict__ dst, float* __restrict__ inv_scale) {
  const int tid = opaque_tid();
  const int lane = tid & 63;
  const int wave = (blockIdx.x * 256 + tid) >> 6, nw = gridDim.x * 4;
  for (int row = wave; row < 16384; row += nw) {
    float4 v[4];
    float mx = 0.f;
#pragma unroll
    for (int i = 0; i < 4; ++i) {
      v[i] = *(const float4*)(src + (size_t)row * 1024 + i * 256 + lane * 4);
      mx = fmaxf(mx, fmaxf(fmaxf(fabsf(v[i].x), fabsf(v[i].y)), fmaxf(fabsf(v[i].z), fabsf(v[i].w))));
    }
    mx = wave_max(mx);
    const float sc = (mx > 1e-30f) ? 127.f / mx : 1.f;
#pragma unroll
    for (int i = 0; i < 4; ++i) {
      const unsigned w = ((unsigned)__float2int_rn(v[i].x * sc) & 255u) | (((unsigned)__float2int_rn(v[i].y * sc) & 255u) << 8) |
                         (((unsigned)__float2int_rn(v[i].z * sc) & 255u) << 16) | (((unsigned)__float2int_rn(v[i].w * sc) & 255u) << 24);
      *(unsigned*)(dst + (size_t)row * 1024 + i * 256 + lane * 4) = w;
    }
    if (lane == 0) inv_scale[row] = (mx > 1e-30f) ? mx * (1.f / 127.f) : 1.f;
  }
}

DI void convert_fp4_rows(const float* __restrict__ src, unsigned char* __restrict__ dst, float* __restrict__ inv_scale) {
  const int tid = opaque_tid();
  const int lane = tid & 63;
  const int wave = (blockIdx.x * 256 + tid) >> 6, nw = gridDim.x * 4;
  for (int row = wave; row < 16384; row += nw) {
    float4 v[4];
    float mx = 0.f;
#pragma unroll
    for (int i = 0; i < 4; ++i) {
      v[i] = *(const float4*)(src + (size_t)row * 1024 + (i >> 1) * 512 + lane * 8 + (i & 1) * 4);
      mx = fmaxf(mx, fmaxf(fmaxf(fabsf(v[i].x), fabsf(v[i].y)), fmaxf(fabsf(v[i].z), fabsf(v[i].w))));
    }
    mx = wave_max(mx);
    const float sc = (mx > 1e-30f) ? 6.f / mx : 1.f;
#pragma unroll
    for (int ps = 0; ps < 2; ++ps) {
      unsigned w = 0u;
      w = __builtin_amdgcn_cvt_scalef32_pk_fp4_f32(w, v[2 * ps].x * sc, v[2 * ps].y * sc, 1.0f, 0);
      w = __builtin_amdgcn_cvt_scalef32_pk_fp4_f32(w, v[2 * ps].z * sc, v[2 * ps].w * sc, 1.0f, 1);
      w = __builtin_amdgcn_cvt_scalef32_pk_fp4_f32(w, v[2 * ps + 1].x * sc, v[2 * ps + 1].y * sc, 1.0f, 2);
      w = __builtin_amdgcn_cvt_scalef32_pk_fp4_f32(w, v[2 * ps + 1].z * sc, v[2 * ps + 1].w * sc, 1.0f, 3);
      *(unsigned*)(dst + (size_t)row * 512 + ps * 256 + lane * 4) = w;
    }
    if (lane == 0) inv_scale[row] = (mx > 1e-30f) ? mx * (1.f / 6.f) : 1.f;
  }
}

DI void transpose_convert(const float* __restrict__ src, ushort_t* __restrict__ dst, int K, int N, float* tile) {
  const int tid = opaque_tid();
  const int tilesN = N / 64, nt = tilesN * (K / 64);
  for (int t = blockIdx.x; t < nt; t += gridDim.x) {
    const int k0 = (t / tilesN) * 64, n0 = (t % tilesN) * 64;
#pragma unroll
    for (int ps = 0; ps < 4; ++ps) {
      const int r = ps * 16 + (tid >> 4), c4 = (tid & 15) * 4;
      const float4 v = *(const float4*)(src + (size_t)(k0 + r) * N + n0 + c4);
      tile[r * 65 + c4 + 0] = v.x; tile[r * 65 + c4 + 1] = v.y; tile[r * 65 + c4 + 2] = v.z; tile[r * 65 + c4 + 3] = v.w;
    }
    __syncthreads();
    const int n = tid >> 2, kc = (tid & 3) * 16;
    unsigned w[8];
#pragma unroll
    for (int i = 0; i < 8; ++i) w[i] = pack2(tile[(kc + 2 * i) * 65 + n], tile[(kc + 2 * i + 1) * 65 + n]);
    uint4* d = (uint4*)(dst + (size_t)(n0 + n) * K + k0 + kc);
    d[0] = make_uint4(w[0], w[1], w[2], w[3]);
    d[1] = make_uint4(w[4], w[5], w[6], w[7]);
    __syncthreads();
  }
}

DI void convert_flat(const float* __restrict__ src, ushort_t* __restrict__ dst, size_t n4) {
  const size_t gt = (size_t)blockIdx.x * 256 + opaque_tid(), gs = (size_t)gridDim.x * 256;
  for (size_t i = gt; i < n4; i += gs) {
    const float4 v = ((const float4*)src)[i];
    ((uint2*)dst)[i] = make_uint2(pack2(v.x, v.y), pack2(v.z, v.w));
  }
}

DI void phase_prologue(const Params& p, char* smem) {
  const int tid = opaque_tid();
  float* sl = (float*)smem;
  float* red = sl + 5 * 1024;
  for (int item = blockIdx.x; item < 192; item += gridDim.x) {
    const int l = item / 96, n0 = (item % 96) * 64;
    for (int i = tid; i < 5 * 1024; i += 256) {
      const int r = i >> 10, k = i & 1023;
      const float v = (r < 4) ? p.c[r * 1024 + k] : p.c_ctx[k];
      sl[i] = v / (1.f + expf(-v));
    }
    __syncthreads();
    const int kg = tid >> 6, col = tid & 63;
    float a0 = 0, a1 = 0, a2 = 0, a3 = 0, a4 = 0;
    const float* w = p.ada_w + (size_t)l * 1024 * 6144 + n0 + col;
#pragma unroll 8
    for (int k = kg * 256; k < kg * 256 + 256; ++k) {
      const float wv = w[(size_t)k * 6144];
      a0 += sl[k] * wv; a1 += sl[1024 + k] * wv; a2 += sl[2048 + k] * wv; a3 += sl[3072 + k] * wv; a4 += sl[4096 + k] * wv;
    }
    red[(kg * 5 + 0) * 64 + col] = a0; red[(kg * 5 + 1) * 64 + col] = a1; red[(kg * 5 + 2) * 64 + col] = a2;
    red[(kg * 5 + 3) * 64 + col] = a3; red[(kg * 5 + 4) * 64 + col] = a4;
    __syncthreads();
    for (int i = tid; i < 320; i += 256) {
      const int r = i >> 6, cc = i & 63;
      const float s = red[(0 * 5 + r) * 64 + cc] + red[(1 * 5 + r) * 64 + cc] + red[(2 * 5 + r) * 64 + cc] + red[(3 * 5 + r) * 64 + cc];
      P_MOD[(l * 5 + r) * 6144 + n0 + cc] = s + p.ada_b[l * 6144 + n0 + cc];
    }
    __syncthreads();
  }
  float* tile = (float*)smem;
  transpose_convert(p.ab_w_in, P_WABIN, 1024, 2304, tile);
  transpose_convert(p.ab_w_out, P_WABOUT, 1024, 1024, tile);
  transpose_convert(p.c_w_in, P_WCIN, 1024, 3072, tile);
  transpose_convert(p.c_w_out, P_WCOUT, 1024, 1024, tile);
  transpose_convert(p.peer_wq, P_WPQ, 1024, 2048, tile);
  transpose_convert(p.peer_wq + (size_t)1024 * 2048, P_WPQ + (size_t)2048 * 1024, 1024, 2048, tile);
  convert_flat(p.peer_keys, P_KEYS, (size_t)2 * 8 * 2 * 128 * 128 / 4);
  const int gt = blockIdx.x * 256 + tid;
  if (gt < 128 * 16) {
    const int pos = gt >> 4, fi = gt & 15;
    const float freq = 1.0f / powf(10000.f, (float)(2 * fi) / 32.f);
    const float ang = (float)pos * freq;
    P_ROPE[gt] = make_float2(cosf(ang), sinf(ang));
  }
  if (blockIdx.x == gridDim.x - 1) {
    float* rb = (float*)smem;
    float mv[8];
    const float* gv[6] = {p.a_qn, p.a_kn, p.b_qn, p.b_kn, p.c_qn, p.c_kn};
#pragma unroll
    for (int k = 0; k < 6; ++k) mv[k] = (tid < 64) ? fabsf(gv[k][tid]) : 0.f;
    float mr = 0.f;
    for (int i = tid; i < 16 * 465; i += 256) mr = fmaxf(mr, fabsf(p.c_rpb[i]));
    mv[6] = mr; mv[7] = 0.f;
    __syncthreads();
#pragma unroll
    for (int k = 0; k < 8; ++k) rb[k * 256 + tid] = mv[k];
    __syncthreads();
    if (tid < 8) {
      float mxv = 0.f;
      for (int i = 0; i < 256; ++i) mxv = fmaxf(mxv, rb[tid * 256 + i]);
      rb[2048 + tid] = mxv;
    }
    __syncthreads();
    if (tid == 0) {
      const float c8 = 8.f * LOG2E;
      P_SCAL[1] = c8 * rb[2048 + 0] * rb[2048 + 1];
      P_SCAL[2] = c8 * rb[2048 + 2] * rb[2048 + 3];
      P_SCAL[3] = c8 * rb[2048 + 4] * rb[2048 + 5] + LOG2E * rb[2048 + 6];
    }
    __syncthreads();
  }
  if (gt == 0) {
    float s1 = 0, s2 = 0;
    for (int i = 0; i < 64; ++i) { s1 += p.b_lam[i] * p.b_lam[64 + i]; s2 += p.b_lam[128 + i] * p.b_lam[192 + i]; }
    P_SCAL[0] = expf(s1) - expf(s2) + 0.2f;
  }
}

DI void phase_norm(const Params& p, int layer, int which) {
  const int tid = opaque_tid();
  const int lane = tid & 63;
  const int wave = (blockIdx.x * 256 + tid) >> 6, nw = gridDim.x * 4;
  const float* g = p.norm_g + (layer * 2 + which) * 1024;
  for (int u = wave; u < NTOK; u += nw) {
    const int b = u / LKB, pp = u - b * LKB;
    const bool isctx = pp < 256;
    if (layer == 1 && which == 1 && isctx) continue;
    const float* src;
    if (layer == 0 && which == 0) src = isctx ? p.ctx + ((size_t)b * 256 + pp) * 1024 : p.x + ((size_t)b * 8192 + (pp - 256)) * 1024;
    else src = P_R + (size_t)u * 1024;
    const int mr = isctx ? 4 : b;
    const float* shift = P_MOD + (layer * 5 + mr) * 6144 + (which ? 3 : 0) * 1024;
    const float* scale = shift + 1024;
    float4 v[4];
    float ss = 0.f;
#pragma unroll
    for (int i = 0; i < 4; ++i) {
      v[i] = *(const float4*)(src + i * 256 + lane * 4);
      ss += v[i].x * v[i].x + v[i].y * v[i].y + v[i].z * v[i].z + v[i].w * v[i].w;
    }
    ss = wave_sum(ss);
    const float rn = rsqrtf(ss * (1.f / 1024.f) + 1e-6f);
#pragma unroll
    for (int i = 0; i < 4; ++i) {
      const int col = i * 256 + lane * 4;
      const float4 g4 = *(const float4*)(g + col), sc = *(const float4*)(scale + col), sh = *(const float4*)(shift + col);
      const float y0 = v[i].x * rn * g4.x * (1.f + sc.x) + sh.x;
      const float y1 = v[i].y * rn * g4.y * (1.f + sc.y) + sh.y;
      const float y2 = v[i].z * rn * g4.z * (1.f + sc.z) + sh.z;
      const float y3 = v[i].w * rn * g4.w * (1.f + sc.w) + sh.w;
      *(uint2*)(P_H + (size_t)u * 1024 + col) = make_uint2(pack2(y0, y1), pack2(y2, y3));
    }
  }
}

DI void gemm_load(const ushort_t* __restrict__ P, const ushort_t* __restrict__ Q, int kt, int srow, int sch, u32x4 (&pr)[4], u32x4 (&qr)[4]) {
#pragma unroll
  for (int ps = 0; ps < 4; ++ps) {
    pr[ps] = *(const u32x4*)(P + (size_t)(srow + 32 * ps) * 1024 + kt * 64 + sch * 8);
    qr[ps] = *(const u32x4*)(Q + (size_t)(srow + 32 * ps) * 1024 + kt * 64 + sch * 8);
  }
}
DI void gemm_write(char* buf, int srow, int sch, const u32x4 (&pr)[4], const u32x4 (&qr)[4]) {
#pragma unroll
  for (int ps = 0; ps < 4; ++ps) {
    *(u32x4*)(buf + swz128(srow + 32 * ps, sch)) = pr[ps];
    *(u32x4*)(buf + 16384 + swz128(srow + 32 * ps, sch)) = qr[ps];
  }
}
DI void gemm_compute(const char* cur, int wi, int wj, int r, int h, f32x16 (&acc)[2][2]) {
  bf16x8 a[2][2], bq[2][2];
#pragma unroll
  for (int mi = 0; mi < 2; ++mi) a[0][mi] = *(const bf16x8*)(cur + swz128(wi * 64 + mi * 32 + r, h));
#pragma unroll
  for (int nj = 0; nj < 2; ++nj) bq[0][nj] = *(const bf16x8*)(cur + 16384 + swz128(wj * 64 + nj * 32 + r, h));
#pragma unroll
  for (int kk = 0; kk < 4; ++kk) {
    if (kk < 3) {
#pragma unroll
      for (int mi = 0; mi < 2; ++mi) a[(kk + 1) & 1][mi] = *(const bf16x8*)(cur + swz128(wi * 64 + mi * 32 + r, (kk + 1) * 2 + h));
#pragma unroll
      for (int nj = 0; nj < 2; ++nj) bq[(kk + 1) & 1][nj] = *(const bf16x8*)(cur + 16384 + swz128(wj * 64 + nj * 32 + r, (kk + 1) * 2 + h));
    }
    __builtin_amdgcn_sched_barrier(0);
#pragma unroll
    for (int mi = 0; mi < 2; ++mi)
#pragma unroll
      for (int nj = 0; nj < 2; ++nj) acc[mi][nj] = MFMA32(a[kk & 1][mi], bq[kk & 1][nj], acc[mi][nj]);
    __builtin_amdgcn_sched_barrier(0);
  }
}
DI void gemm_dma(const ushort_t* __restrict__ P, const ushort_t* __restrict__ Q, int kt, char* buf, int srow, int csrc, int wid) {
#pragma unroll
  for (int ps = 0; ps < 4; ++ps) {
    const size_t go = (size_t)(srow + 32 * ps) * 1024 + kt * 64 + csrc * 8;
    __builtin_amdgcn_global_load_lds((const unsigned*)(P + go), (unsigned*)(buf + ps * 4096 + wid * 1024), 16, 0, 0);
    __builtin_amdgcn_global_load_lds((const unsigned*)(Q + go), (unsigned*)(buf + 16384 + ps * 4096 + wid * 1024), 16, 0, 0);
  }
}
DI void gemm_main(const ushort_t* __restrict__ P, const ushort_t* __restrict__ Q, char* smem, f32x16 (&acc)[2][2], const int tid) {
  const int lane = tid & 63, w = tid >> 6, wi = w >> 1, wj = w & 1;
  const int r = lane & 31, h = lane >> 5;
  const int srow = tid >> 3, csrc = (tid & 7) ^ ((srow >> 1) & 7);
  const int wid = __builtin_amdgcn_readfirstlane(w);
  gemm_dma(P, Q, 0, smem, srow, csrc, wid);
  asm volatile("s_waitcnt vmcnt(0)" ::: "memory");
  __syncthreads();
#pragma unroll 1
  for (int kt = 0; kt < 16; ++kt) {
    char* cur = smem + (kt & 1) * 32768;
    char* nxt = smem + ((kt + 1) & 1) * 32768;
    if (kt + 1 < 16) gemm_dma(P, Q, kt + 1, nxt, srow, csrc, wid);
    gemm_compute(cur, wi, wj, r, h, acc);
    asm volatile("s_waitcnt vmcnt(0)" ::: "memory");
    __syncthreads();
  }
}

DI void zero_acc(f32x16 (&acc)[2][2]) {
#pragma unroll
  for (int a = 0; a < 2; ++a)
#pragma unroll
    for (int b = 0; b < 2; ++b)
#pragma unroll
      for (int i = 0; i < 16; ++i) acc[a][b][i] = 0.f;
}

DI void phase_qkv(const Params& p, int layer, char* smem) {
  const int tid = opaque_tid(), lane = tid & 63, w = tid >> 6, wi = w >> 1, wj = w & 1;
  const int r = lane & 31, h = lane >> 5;
  const int NI = layer == 0 ? 18 : 24;
  const ushort_t* W = layer == 0 ? P_WABIN : P_WCIN;
  const int ntiles = NI * 264;
  constexpr int SST = 272;
  for (int id = blockIdx.x; id < ntiles; id += gridDim.x) {
    const int jt = id / NI, it = id - jt * NI;
    const int f0 = it * 128, t0 = jt * 128;
    const int hu0 = f0 >> 6;
    int kind, dcol0;
    const float* gain;
    if (layer == 0) {
      if (hu0 < 8) { kind = 0; dcol0 = hu0 * 64; gain = p.a_qn; }
      else if (hu0 < 10) { kind = 1; dcol0 = (hu0 - 8) * 64; gain = p.a_kn; }
      else if (hu0 < 12) { kind = 2; dcol0 = (hu0 - 10) * 64; gain = p.a_qn; }
      else if (hu0 < 20) { kind = 0; dcol0 = 512 + (hu0 - 12) * 64; gain = p.b_qn; }
      else if (hu0 < 28) { kind = 1; dcol0 = 128 + (hu0 - 20) * 64; gain = p.b_kn; }
      else { kind = 2; dcol0 = 128 + (hu0 - 28) * 64; gain = p.a_qn; }
    } else {
      if (hu0 < 16) { kind = 0; dcol0 = hu0 * 64; gain = p.c_qn; }
      else if (hu0 < 32) { kind = 1; dcol0 = (hu0 - 16) * 64; gain = p.c_kn; }
      else { kind = 2; dcol0 = (hu0 - 32) * 64; gain = p.c_qn; }
    }
    const int b = t0 / LKB;
    const int pp0 = t0 - b * LKB;
    f32x16 acc[2][2];
    zero_acc(acc);
    if (kind == 2) gemm_main(P_H + (size_t)t0 * 1024, W + (size_t)f0 * 1024, smem, acc, tid);
    else gemm_main(W + (size_t)f0 * 1024, P_H + (size_t)t0 * 1024, smem, acc, tid);
    char* stg = smem;
#pragma unroll
    for (int nj = 0; nj < 2; ++nj) {
      const int jrow = wj * 64 + nj * 32 + r;
      char* srow_p = stg + jrow * SST + (wi * 64 + 4 * h) * 2;
      if (kind == 2) {
#pragma unroll
        for (int mi = 0; mi < 2; ++mi)
#pragma unroll
          for (int g = 0; g < 4; ++g)
            *(uint2*)(srow_p + (mi * 32 + 8 * g) * 2) = make_uint2(pack2(acc[mi][nj][4 * g], acc[mi][nj][4 * g + 1]),
                                                                  pack2(acc[mi][nj][4 * g + 2], acc[mi][nj][4 * g + 3]));
      } else {
        const int pp = pp0 + jrow;
        float ss = 0.f;
#pragma unroll
        for (int mi = 0; mi < 2; ++mi)
#pragma unroll
          for (int reg = 0; reg < 16; ++reg) ss += acc[mi][nj][reg] * acc[mi][nj][reg];
        ss += __shfl_xor(ss, 32);
        const float rn = rsqrtf(ss * (1.f / 64.f) + 1e-6f);
        const float sc = (kind == 0) ? 0.125f * LOG2E : 1.f;
        const bool rope = (layer == 0) && (pp >= 256);
        const int s = pp - 256;
#pragma unroll
        for (int mi = 0; mi < 2; ++mi) {
          float v[16];
#pragma unroll
          for (int reg = 0; reg < 16; ++reg) v[reg] = acc[mi][nj][reg] * rn * gain[mi * 32 + crow(reg, h)];
          if (rope) {
            const int ps = (mi == 0) ? (s >> 6) : (s & 63);
#pragma unroll
            for (int q = 0; q < 8; ++q) {
              const float2 cs = P_ROPE[ps * 16 + crow(q, h)];
              const float x1 = v[q], x2 = v[q + 8];
              v[q] = x1 * cs.x - x2 * cs.y;
              v[q + 8] = x1 * cs.y + x2 * cs.x;
            }
          }
#pragma unroll
          for (int g = 0; g < 4; ++g)
            *(uint2*)(srow_p + (mi * 32 + 8 * g) * 2) =
                make_uint2(pack2(v[4 * g] * sc, v[4 * g + 1] * sc), pack2(v[4 * g + 2] * sc, v[4 * g + 3] * sc));
        }
      }
    }
    __syncthreads();
    ushort_t* obase;
    size_t ostride;
    if (kind == 2) { obase = P_VT + ((size_t)(b * 1024 + dcol0)) * LKB + pp0; ostride = LKB; }
    else { obase = (kind == 0 ? P_QB : P_KB) + (size_t)t0 * 1024 + dcol0; ostride = 1024; }
#pragma unroll
    for (int i = 0; i < 8; ++i) {
      const int idx = tid + 256 * i;
      const int row = idx >> 4, ch = idx & 15;
      const u32x4 val = *(const u32x4*)(stg + row * SST + ch * 16);
      *(u32x4*)(obase + (size_t)row * ostride + ch * 8) = val;
    }
    __syncthreads();
  }
}

DI void phase_outproj(const Params& p, int layer, char* smem) {
  const int tid = opaque_tid(), lane = tid & 63, w = tid >> 6, wi = w >> 1, wj = w & 1;
  const int r = lane & 31, h = lane >> 5;
  const ushort_t* W = layer == 0 ? P_WABOUT : P_WCOUT;
  const int ntok_tiles = layer == 0 ? 264 : 256;
  for (int id = blockIdx.x; id < ntok_tiles * 8; id += gridDim.x) {
    int it = id >> 3;
    const int jt = id & 7;
    if (layer == 1) it = (it >> 6) * 66 + 2 + (it & 63);
    const int i0 = it * 128, j0 = jt * 128;
    f32x16 acc[2][2];
    zero_acc(acc);
    gemm_main(P_H + (size_t)i0 * 1024, W + (size_t)j0 * 1024, smem, acc, tid);
    const int b = i0 / LKB, pp0 = i0 - b * LKB;
    const bool isctx = pp0 < 256;
    const int mr = isctx ? 4 : b;
    const float* gate = P_MOD + (layer * 5 + mr) * 6144 + 2 * 1024;
    const float* xin_base;
    if (layer == 0) xin_base = isctx ? p.ctx + ((size_t)b * 256 + pp0) * 1024 : p.x + ((size_t)b * 8192 + (pp0 - 256)) * 1024;
    else xin_base = P_R + (size_t)i0 * 1024;
    float* r_base = P_R + (size_t)i0 * 1024 + j0;
    xin_base += j0;
    unsigned lane_off = (unsigned)((wi * 64 + 4 * h) * 1024 + wj * 64 + r);
    asm volatile("" : "+v"(lane_off));
#pragma unroll
    for (int nj = 0; nj < 2; ++nj) {
      const float gt = gate[j0 + wj * 64 + nj * 32 + r];
#pragma unroll
      for (int mi = 0; mi < 2; ++mi) {
        float xin[16];
#pragma unroll
        for (int reg = 0; reg < 16; ++reg)
          xin[reg] = xin_base[lane_off + (unsigned)((mi * 32 + (reg & 3) + 8 * (reg >> 2)) * 1024 + nj * 32)];
#pragma unroll
        for (int reg = 0; reg < 16; ++reg)
          r_base[lane_off + (unsigned)((mi * 32 + (reg & 3) + 8 * (reg >> 2)) * 1024 + nj * 32)] = xin[reg] + gt * acc[mi][nj][reg];
      }
    }
  }
}

template <int NDF, int MODE, int DEAD = -1>
DI bool attn_tile(const bool safe, const bool zref, const char* Ks, const char* Vs, const bf16x8 (&qf)[4], f32x16 (&O)[NDF], float& mref, float& l,
                  const bool first, int lane, int cs, const float* bias_row) {
  const int r = lane & 31, h = lane >> 5;
  const int pr = (r & ~12) | ((r & 4) << 1) | ((r & 8) >> 1);
  f32x16 S[2];
  {
    const bf16x8 a0 = *(const bf16x8*)(Ks + swz128(pr, h));
    const bf16x8 a1 = *(const bf16x8*)(Ks + swz128(32 + pr, h));
    if (zref) {
      f32x16 z;
#pragma unroll
      for (int i = 0; i < 16; ++i) z[i] = 0.f;
      S[0] = MFMA32(a0, qf[0], z);
      S[1] = MFMA32(a1, qf[0], z);
    } else {
      f32x16 z;
      const float sinit = -mref;
#pragma unroll
      for (int i = 0; i < 16; ++i) z[i] = sinit;
      S[0] = MFMA32(a0, qf[0], z);
      S[1] = MFMA32(a1, qf[0], z);
    }
  }
#pragma unroll
  for (int kk = 1; kk < 4; ++kk)
#pragma unroll
    for (int kf = 0; kf < 2; ++kf) {
      const bf16x8 a = *(const bf16x8*)(Ks + swz128(kf * 32 + pr, kk * 2 + h));
      S[kf] = MFMA32(a, qf[kk], S[kf]);
    }
  if (MODE == 1) {
    const float* brow = bias_row + 8 * h;
    const int csh = cs - 8 * h;
#pragma unroll
    for (int kf = 0; kf < 2; ++kf) {
#pragma unroll
      for (int reg = 0; reg < 16; ++reg) {
        if (kf * 2 + (reg >> 3) == DEAD) continue;
        const int kc0 = kf * 32 + 16 * (reg >> 3) + (reg & 7);
        const bool valid = (unsigned)(kc0 - csh) < 16u;
        S[kf][reg] = valid ? S[kf][reg] + brow[kc0] : -INFINITY;
      }
      __builtin_amdgcn_sched_barrier(0);
    }
  }
  bool slow = false;
  if (!safe) {
  float mx = -INFINITY;
#pragma unroll
  for (int kf = 0; kf < 2; ++kf)
#pragma unroll
    for (int reg = 0; reg < 16; ++reg) {
      if (kf * 2 + (reg >> 3) == DEAD) continue;
      mx = fmaxf(mx, S[kf][reg]);
    }
  const bool ok = first ? (fabsf(mx) <= 20.f) : (mx <= 20.f);
  slow = !__all(ok);
  if (slow) {
    mx = fmaxf(mx, __shfl_xor(mx, 32));
    const float mnew = first ? fmaxf(mx, -64.f) : fmaxf(mx, 0.f);
    const float alpha = __builtin_amdgcn_exp2f(-mnew);
    mref += mnew;
    l *= alpha;
#pragma unroll
    for (int kf = 0; kf < 2; ++kf)
#pragma unroll
      for (int reg = 0; reg < 16; ++reg) S[kf][reg] -= mnew;
#pragma unroll
    for (int df = 0; df < NDF; ++df)
#pragma unroll
      for (int i = 0; i < 16; ++i) O[df][i] *= alpha;
  }
  }
  float rs = 0.f;
#pragma unroll
  for (int kf = 0; kf < 2; ++kf)
#pragma unroll
    for (int reg = 0; reg < 16; ++reg) {
      if (kf * 2 + (reg >> 3) == DEAD) continue;
      const float pv = __builtin_amdgcn_exp2f(S[kf][reg]);
      S[kf][reg] = pv;
      rs += pv;
    }
  l += rs;
#pragma unroll
  for (int kf = 0; kf < 2; ++kf)
#pragma unroll
    for (int s2 = 0; s2 < 2; ++s2) {
      if (kf * 2 + s2 == DEAD) continue;
      const unsigned w0 = pack2(S[kf][8 * s2 + 0], S[kf][8 * s2 + 1]), w1 = pack2(S[kf][8 * s2 + 2], S[kf][8 * s2 + 3]);
      const unsigned w2 = pack2(S[kf][8 * s2 + 4], S[kf][8 * s2 + 5]), w3 = pack2(S[kf][8 * s2 + 6], S[kf][8 * s2 + 7]);
      const uint4 pk = make_uint4(w0, w1, w2, w3);
      const bf16x8 pb = __builtin_bit_cast(bf16x8, pk);
      const int ks = kf * 2 + s2;
#pragma unroll
      for (int df = 0; df < NDF; ++df) {
        const bf16x8 a = *(const bf16x8*)(Vs + swz128(df * 32 + r, ks * 2 + h));
        O[df] = MFMA32(a, pb, O[df]);
      }
    }
  return slow;
}
template <int NDF, int MODE, int DEAD = -1>
DI void attn_tile_z(const bool safe, bool& zref, const char* Ks, const char* Vs, const bf16x8 (&qf)[4], f32x16 (&O)[NDF], float& mref, float& l,
                    const bool first, int lane, int cs, const float* bias_row) {
  const bool slow = attn_tile<NDF, MODE, DEAD>(safe, zref, Ks, Vs, qf, O, mref, l, first, lane, cs, bias_row);
  if (slow) zref = __all(mref == 0.f) != 0;
}

template <int KM, int NDF>
DI void attn_stage_load(const Params& p, size_t krow_u, int kcol, size_t vt_row0, int vt_col, u32x4 (&kr)[2 * KM], u32x4 (&vr)[NDF], const int tid) {
#pragma unroll
  for (int i = 0; i < 2 * KM; ++i) {
    const int id = tid + 256 * i;
    const int row = id / (8 * KM), c = id % (8 * KM);
    kr[i] = *(const u32x4*)(P_KB + (krow_u + row) * 1024 + kcol + c * 8);
  }
#pragma unroll
  for (int i = 0; i < NDF; ++i) {
    const int id = tid + 256 * i;
    const int row = id >> 3, c = id & 7;
    vr[i] = *(const u32x4*)(P_VT + (vt_row0 + row) * LKB + vt_col + c * 8);
  }
}
template <int KM, int NDF>
DI void attn_stage_write(char* buf, const u32x4 (&kr)[2 * KM], const u32x4 (&vr)[NDF], const int tid) {
#pragma unroll
  for (int i = 0; i < 2 * KM; ++i) {
    const int id = tid + 256 * i;
    const int row = id / (8 * KM), c = id % (8 * KM);
    *(u32x4*)(buf + (c >> 3) * 8192 + swz128(row, c & 7)) = kr[i];
  }
#pragma unroll
  for (int i = 0; i < NDF; ++i) {
    const int id = tid + 256 * i;
    const int row = id >> 3, c = id & 7;
    *(u32x4*)(buf + KM * 8192 + swz128(row, c)) = vr[i];
  }
}

template <int KM, int NDF>
DI void attn_stage_dma(const Params& p, size_t krow_u, int kcol, size_t vt_row0, int vt_col, char* buf, const int tid) {
  const int lane = tid & 63, lr = lane >> 3, pc = lane & 7;
  const int wid = __builtin_amdgcn_readfirstlane(tid >> 6);
#pragma unroll
  for (int i = 0; i < 2 * KM; ++i) {
    const int pcs = i * 4 + wid, mat = pcs >> 3, prow0 = (pcs & 7) * 8;
    const int row = prow0 + lr, lc = pc ^ ((row >> 1) & 7);
    __builtin_amdgcn_global_load_lds((const unsigned*)(P_KB + (krow_u + row) * 1024 + kcol + mat * 64 + lc * 8),
                                     (unsigned*)(buf + mat * 8192 + prow0 * 128), 16, 0, 0);
  }
#pragma unroll
  for (int i = 0; i < NDF; ++i) {
    const int prow0 = (i * 4 + wid) * 8;
    const int row = prow0 + lr, lc = pc ^ ((row >> 1) & 7);
    __builtin_amdgcn_global_load_lds((const unsigned*)(P_VT + (vt_row0 + row) * LKB + vt_col + lc * 8),
                                     (unsigned*)(buf + KM * 8192 + prow0 * 128), 16, 0, 0);
  }
}

DI void load_qfrags(const ushort_t* qptr, int lane, bf16x8 (&qf)[4]) {
  const int r = lane & 31, h = lane >> 5;
#pragma unroll
  for (int kk = 0; kk < 4; ++kk) qf[kk] = *(const bf16x8*)(qptr + (size_t)r * 1024 + kk * 16 + 8 * h);
}

template <int DIFF>
DI void attn_item_l0(const Params& p, char* smem, int b, int head, int q0, int nt) {
  constexpr int KM = DIFF ? 2 : 1, NDF = DIFF ? 4 : 2;
  constexpr int BUFB = KM * 8192 + NDF * 4096;
  const int tid = opaque_tid(), lane = tid & 63, w = tid >> 6;
  const int r = lane & 31, h = lane >> 5;
  int qoff, qcol, km, kcol, vfeat;
  if (DIFF) { qoff = (w >> 1) * 32; km = w & 1; qcol = 512 + (head * 2 + km) * 64; kcol = 128 + head * 128; vfeat = 128 + head * 128; }
  else { qoff = w * 32; km = 0; qcol = head * 64; kcol = (head >> 2) * 64; vfeat = (head >> 2) * 64; }
  const size_t ub = (size_t)b * LKB;
  bf16x8 qf[4];
  load_qfrags(P_QB + (ub + q0 + qoff) * 1024 + qcol, lane, qf);
  f32x16 O[NDF];
#pragma unroll
  for (int df = 0; df < NDF; ++df)
#pragma unroll
    for (int i = 0; i < 16; ++i) O[df][i] = 0.f;
  float m = 0.f, l = 0.f;
  bool zref = true;
  const bool safe = P_SCAL[DIFF ? 2 : 1] <= 20.f;
  const size_t vt_row0 = (size_t)b * 1024 + vfeat;
  attn_stage_dma<KM, NDF>(p, ub, kcol, vt_row0, 0, smem, tid);
  asm volatile("s_waitcnt vmcnt(0)" ::: "memory");
  __syncthreads();
#pragma unroll 1
  for (int t = 0; t < nt; ++t) {
    char* cur = smem + (t & 1) * BUFB;
    char* nxt = smem + ((t + 1) & 1) * BUFB;
    if (t + 1 < nt) attn_stage_dma<KM, NDF>(p, ub + (t + 1) * 64, kcol, vt_row0, (t + 1) * 64, nxt, tid);
    attn_tile_z<NDF, 0>(safe, zref, cur + km * 8192, cur + KM * 8192, qf, O, m, l, t == 0, lane, 0, nullptr);
    asm volatile("s_waitcnt vmcnt(0)" ::: "memory");
    __syncthreads();
  }
  const float lt = l + __shfl_xor(l, 32);
  const float inv = 1.f / lt;
  const size_t uq = ub + q0 + qoff + r;
  if (!DIFF) {
    ushort_t* dst = P_H + uq * 1024 + head * 64;
#pragma unroll
    for (int df = 0; df < NDF; ++df)
#pragma unroll
      for (int g = 0; g < 4; ++g)
        *(uint2*)(dst + df * 32 + 8 * g + 4 * h) = make_uint2(pack2(O[df][4 * g] * inv, O[df][4 * g + 1] * inv),
                                                              pack2(O[df][4 * g + 2] * inv, O[df][4 * g + 3] * inv));
  } else {
    float* mg = (float*)smem;
    if (km == 1) {
#pragma unroll
      for (int df = 0; df < NDF; ++df)
#pragma unroll
        for (int i = 0; i < 16; ++i) mg[((w >> 1) * 64 + df * 16 + i) * 64 + lane] = O[df][i] * inv;
    }
    __syncthreads();
    if (km == 0) {
      const float lam = P_SCAL[0];
      float ss = 0.f;
#pragma unroll
      for (int df = 0; df < NDF; ++df)
#pragma unroll
        for (int i = 0; i < 16; ++i) {
          const float v = O[df][i] * inv - lam * mg[((w >> 1) * 64 + df * 16 + i) * 64 + lane];
          O[df][i] = v;
          ss += v * v;
        }
      ss += __shfl_xor(ss, 32);
      const float rn = rsqrtf(ss * (1.f / 128.f) + 1e-6f) * 0.8f;
      ushort_t* dst = P_H + uq * 1024 + 512 + head * 128;
#pragma unroll
      for (int df = 0; df < NDF; ++df)
#pragma unroll
        for (int g = 0; g < 4; ++g) {
          const int d = df * 32 + 8 * g + 4 * h;
          const float4 sg = *(const float4*)(p.b_subln + d);
          *(uint2*)(dst + d) = make_uint2(pack2(O[df][4 * g] * rn * sg.x, O[df][4 * g + 1] * rn * sg.y),
                                          pack2(O[df][4 * g + 2] * rn * sg.z, O[df][4 * g + 3] * rn * sg.w));
        }
    }
    __syncthreads();
  }
}

DI bool attn_tile2(const bool safe, const bool zref, const char* Ks, const char* Vs, const bf16x8 (&qf)[2][4], f32x16 (&O)[2][2], float (&mref)[2],
                   float (&l)[2], const bool first, int lane) {
  const int r = lane & 31, h = lane >> 5;
  const int pr = (r & ~12) | ((r & 4) << 1) | ((r & 8) >> 1);
  f32x16 S[2][2];
  {
    const bf16x8 a0 = *(const bf16x8*)(Ks + swz128(pr, h));
    const bf16x8 a1 = *(const bf16x8*)(Ks + swz128(32 + pr, h));
    if (zref) {
      f32x16 z;
#pragma unroll
      for (int i = 0; i < 16; ++i) z[i] = 0.f;
#pragma unroll
      for (int q = 0; q < 2; ++q) { S[q][0] = MFMA32(a0, qf[q][0], z); S[q][1] = MFMA32(a1, qf[q][0], z); }
    } else {
#pragma unroll
      for (int q = 0; q < 2; ++q) {
        f32x16 z;
        const float sinit = -mref[q];
#pragma unroll
        for (int i = 0; i < 16; ++i) z[i] = sinit;
        S[q][0] = MFMA32(a0, qf[q][0], z);
        S[q][1] = MFMA32(a1, qf[q][0], z);
      }
    }
  }
#pragma unroll
  for (int kk = 1; kk < 4; ++kk)
#pragma unroll
    for (int kf = 0; kf < 2; ++kf) {
      const bf16x8 a = *(const bf16x8*)(Ks + swz128(kf * 32 + pr, kk * 2 + h));
#pragma unroll
      for (int q = 0; q < 2; ++q) S[q][kf] = MFMA32(a, qf[q][kk], S[q][kf]);
    }
  bool slow = false;
  if (!safe) {
  float mx[2];
#pragma unroll
  for (int q = 0; q < 2; ++q) {
    mx[q] = S[q][0][0];
#pragma unroll
    for (int kf = 0; kf < 2; ++kf)
#pragma unroll
      for (int reg = 0; reg < 16; ++reg) mx[q] = fmaxf(mx[q], S[q][kf][reg]);
  }
  const bool ok = first ? (fabsf(mx[0]) <= 20.f && fabsf(mx[1]) <= 20.f) : (fmaxf(mx[0], mx[1]) <= 20.f);
  slow = !__all(ok);
  if (slow) {
#pragma unroll
    for (int q = 0; q < 2; ++q) {
      const float mxq = fmaxf(mx[q], __shfl_xor(mx[q], 32));
      const float mnew = first ? fmaxf(mxq, -64.f) : fmaxf(mxq, 0.f);
      const float alpha = __builtin_amdgcn_exp2f(-mnew);
      mref[q] += mnew;
      l[q] *= alpha;
#pragma unroll
      for (int kf = 0; kf < 2; ++kf)
#pragma unroll
        for (int reg = 0; reg < 16; ++reg) S[q][kf][reg] -= mnew;
#pragma unroll
      for (int df = 0; df < 2; ++df)
#pragma unroll
        for (int i = 0; i < 16; ++i) O[q][df][i] *= alpha;
    }
  }
  }
#pragma unroll
  for (int q = 0; q < 2; ++q) {
    float rs = 0.f;
#pragma unroll
    for (int kf = 0; kf < 2; ++kf)
#pragma unroll
      for (int reg = 0; reg < 16; ++reg) {
        const float pv = __builtin_amdgcn_exp2f(S[q][kf][reg]);
        S[q][kf][reg] = pv;
        rs += pv;
      }
    l[q] += rs;
  }
#pragma unroll
  for (int kf = 0; kf < 2; ++kf)
#pragma unroll
    for (int s2 = 0; s2 < 2; ++s2) {
      bf16x8 pb[2];
#pragma unroll
      for (int q = 0; q < 2; ++q) {
        const uint4 pk = make_uint4(pack2(S[q][kf][8 * s2 + 0], S[q][kf][8 * s2 + 1]), pack2(S[q][kf][8 * s2 + 2], S[q][kf][8 * s2 + 3]),
                                    pack2(S[q][kf][8 * s2 + 4], S[q][kf][8 * s2 + 5]), pack2(S[q][kf][8 * s2 + 6], S[q][kf][8 * s2 + 7]));
        pb[q] = __builtin_bit_cast(bf16x8, pk);
      }
      const int ks = kf * 2 + s2;
#pragma unroll
      for (int df = 0; df < 2; ++df) {
        const bf16x8 a = *(const bf16x8*)(Vs + swz128(df * 32 + r, ks * 2 + h));
#pragma unroll
        for (int q = 0; q < 2; ++q) O[q][df] = MFMA32(a, pb[q], O[q][df]);
      }
    }
  return slow;
}

DI void attn_item_gqa2(const Params& p, char* smem, int b, int head, int q0, int nt) {
  constexpr int BUFB = 16384;
  const int tid = opaque_tid(), lane = tid & 63, w = tid >> 6;
  const int r = lane & 31, h = lane >> 5;
  const int qoff = w * 64, qcol = head * 64, kcol = (head >> 2) * 64, vfeat = (head >> 2) * 64;
  const size_t ub = (size_t)b * LKB;
  bf16x8 qf[2][4];
  load_qfrags(P_QB + (ub + q0 + qoff) * 1024 + qcol, lane, qf[0]);
  load_qfrags(P_QB + (ub + q0 + qoff + 32) * 1024 + qcol, lane, qf[1]);
  f32x16 O[2][2];
#pragma unroll
  for (int q = 0; q < 2; ++q)
#pragma unroll
    for (int df = 0; df < 2; ++df)
#pragma unroll
      for (int i = 0; i < 16; ++i) O[q][df][i] = 0.f;
  float m[2] = {0.f, 0.f}, l[2] = {0.f, 0.f};
  bool zref = true;
  const bool safe = P_SCAL[1] <= 20.f;
  const size_t vt_row0 = (size_t)b * 1024 + vfeat;
  attn_stage_dma<1, 2>(p, ub, kcol, vt_row0, 0, smem, tid);
  asm volatile("s_waitcnt vmcnt(0)" ::: "memory");
  __syncthreads();
#pragma unroll 1
  for (int t = 0; t < nt; ++t) {
    char* cur = smem + (t & 1) * BUFB;
    char* nxt = smem + ((t + 1) & 1) * BUFB;
    if (t + 1 < nt) attn_stage_dma<1, 2>(p, ub + (t + 1) * 64, kcol, vt_row0, (t + 1) * 64, nxt, tid);
    const bool slow = attn_tile2(safe, zref, cur, cur + 8192, qf, O, m, l, t == 0, lane);
    if (slow) zref = __all(m[0] == 0.f && m[1] == 0.f) != 0;
    asm volatile("s_waitcnt vmcnt(0)" ::: "memory");
    __syncthreads();
  }
#pragma unroll
  for (int q = 0; q < 2; ++q) {
    const float lt = l[q] + __shfl_xor(l[q], 32);
    const float inv = 1.f / lt;
    ushort_t* dst = P_H + (ub + q0 + qoff + q * 32 + r) * 1024 + head * 64;
#pragma unroll
    for (int df = 0; df < 2; ++df)
#pragma unroll
      for (int g = 0; g < 4; ++g)
        *(uint2*)(dst + df * 32 + 8 * g + 4 * h) = make_uint2(pack2(O[q][df][4 * g] * inv, O[q][df][4 * g + 1] * inv),
                                                              pack2(O[q][df][4 * g + 2] * inv, O[q][df][4 * g + 3] * inv));
  }
}

DI void phase_attn_l0(const Params& p, char* smem) {
  const int xcd = blockIdx.x & 7, lb = blockIdx.x >> 3, nbx = gridDim.x >> 3;
  for (int it = lb; it < 132; it += nbx) {
    if (it < 128) {
      const int b = xcd >> 1, hq = (xcd & 1) * 4 + (it >> 5), qb = it & 31;
      attn_item_gqa2(p, smem, b, hq, 256 + qb * 256, 132);
    } else {
      const int b = xcd >> 1, hq = (xcd & 1) * 4 + (it - 128);
      attn_item_gqa2(p, smem, b, hq, 0, 4);
    }
  }
  for (int it = lb; it < 264; it += nbx) {
    if (it < 256) {
      const int combo = xcd * 2 + (it >> 7), qb = it & 127;
      attn_item_l0<1>(p, smem, combo >> 2, combo & 3, 256 + qb * 64, 132);
    } else {
      const int j = it - 256, combo = xcd * 2 + (j >> 2), qb = j & 3;
      attn_item_l0<1>(p, smem, combo >> 2, combo & 3, qb * 64, 4);
    }
  }
}

DI int rs_of(int row) { return min(max(row - 4, 0), 120); }
DI void phase_attn_l1(const Params& p, char* smem) {
  constexpr int BUFB = 16384;
  const int tid = opaque_tid(), lane = tid & 63, w = tid >> 6;
  const int r = lane & 31, h = lane >> 5;
  float* rpbL = (float*)(smem + 32768);
  int cur_h = -1;
  for (int it = blockIdx.x; it < 4096; it += gridDim.x) {
    const int b = it >> 10, rp = (it >> 4) & 63, hh = it & 15;
    const int r0 = rp * 2;
    const int rsA = rs_of(r0), rsB = rs_of(r0 + 1) + 7;
    const int nwin = rsB - rsA + 1, nt = nwin + 4;
    const int row = r0 + (w >> 1), qfi = w & 1;
    const int rsw = rs_of(row);
    const int j = qfi * 32 + r;
    const int cs = min(max(j - 8, 0), 48);
    const size_t ub = (size_t)b * LKB;
    if (hh != cur_h) {
      __syncthreads();
      for (int i = tid; i < 465; i += 256) rpbL[i] = p.c_rpb[hh * 465 + i] * LOG2E;
      cur_h = hh;
    }
    bf16x8 qf[4];
    load_qfrags(P_QB + (ub + 256 + row * 64 + qfi * 32) * 1024 + hh * 64, lane, qf);
    f32x16 O[2];
#pragma unroll
    for (int df = 0; df < 2; ++df)
#pragma unroll
      for (int i = 0; i < 16; ++i) O[df][i] = 0.f;
    float m = 0.f, l = 0.f;
    bool zref = true;
    const bool safe = P_SCAL[3] <= 20.f;
    const size_t vt_row0 = (size_t)b * 1024 + hh * 64;
    {
      const int kp = 256 + rsA * 64;
      attn_stage_dma<1, 2>(p, ub + kp, hh * 64, vt_row0, kp, smem, tid);
    }
    asm volatile("s_waitcnt vmcnt(0)" ::: "memory");
    __syncthreads();
#pragma unroll 1
    for (int t = 0; t < nt; ++t) {
      char* cur = smem + (t & 1) * BUFB;
      char* nxt = smem + ((t + 1) & 1) * BUFB;
      if (t + 1 < nt) {
        const int kp = (t + 1 < nwin) ? 256 + (rsA + t + 1) * 64 : (t + 1 - nwin) * 64;
        attn_stage_dma<1, 2>(p, ub + kp, hh * 64, vt_row0, kp, nxt, tid);
      }
      if (t < nwin) {
        const int krw = rsA + t;
        const bool inband = (krw >= rsw) && (krw <= rsw + 7);
        if (__builtin_amdgcn_readfirstlane(qfi) == 0)
          attn_tile_z<2, 1, 3>(safe, zref, cur, cur + 8192, qf, O, m, l, krw == rsw, lane, inband ? cs : 1000, rpbL + (krw - row + 7) * 31 + 15 - j);
        else
          attn_tile_z<2, 1, 0>(safe, zref, cur, cur + 8192, qf, O, m, l, krw == rsw, lane, inband ? cs : 1000, rpbL + (krw - row + 7) * 31 + 15 - j);
      } else {
        attn_tile_z<2, 0>(safe, zref, cur, cur + 8192, qf, O, m, l, false, lane, 0, nullptr);
      }
      asm volatile("s_waitcnt vmcnt(0)" ::: "memory");
      __syncthreads();
    }
    const float lt = l + __shfl_xor(l, 32);
    const float inv = 1.f / lt;
    ushort_t* dst = P_H + (ub + 256 + row * 64 + j) * 1024 + hh * 64;
#pragma unroll
    for (int df = 0; df < 2; ++df)
#pragma unroll
      for (int g = 0; g < 4; ++g)
        *(uint2*)(dst + df * 32 + 8 * g + 4 * h) = make_uint2(pack2(O[df][4 * g] * inv, O[df][4 * g + 1] * inv),
                                                              pack2(O[df][4 * g + 2] * inv, O[df][4 * g + 3] * inv));
  }
}

DI void phase_peerq(const Params& p, int layer, char* smem) {
  const int tid = opaque_tid(), lane = tid & 63, w = tid >> 6, wi_ = w >> 1, wj_ = w & 1;
  const int r_ = lane & 31, h_ = lane >> 5;
  const int ntok_tiles = layer == 0 ? 264 : 256;
  for (int id = blockIdx.x; id < ntok_tiles * 16; id += gridDim.x) {
    int jt = id >> 4;
    const int it = id & 15;
    if (layer == 1) jt = (jt >> 6) * 66 + 2 + (jt & 63);
    const int j0 = jt * 128;
    f32x16 acc[2][2];
    zero_acc(acc);
    gemm_main(P_WPQ + ((size_t)layer * 2048 + it * 128) * 1024, P_H + (size_t)j0 * 1024, smem, acc, tid);
    char* pqs = smem;
    char* kss = smem + 32768;
    int r = r_, h = h_, wi = wi_, wj = wj_;
    asm volatile("" : "+v"(r), "+v"(h), "+v"(wi), "+v"(wj));
#pragma unroll
    for (int nj = 0; nj < 2; ++nj) {
      const int tok = wj * 64 + nj * 32 + r;
#pragma unroll
      for (int mi = 0; mi < 2; ++mi)
#pragma unroll
        for (int g = 0; g < 4; ++g) {
          const int d = wi * 64 + mi * 32 + 8 * g + 4 * h;
          *(uint2*)(pqs + swz256(tok, d >> 3) + (d & 7) * 2) =
              make_uint2(pack2(acc[mi][nj][4 * g], acc[mi][nj][4 * g + 1]), pack2(acc[mi][nj][4 * g + 2], acc[mi][nj][4 * g + 3]));
        }
    }
    const ushort_t* kg = P_KEYS + ((size_t)layer * 16 + it) * 128 * 128;
#pragma unroll
    for (int i = 0; i < 8; ++i) {
      const int idc = tid + 256 * i;
      const int row = idc >> 4, c = idc & 15;
      *(uint4*)(kss + swz256(row, c)) = *(const uint4*)(kg + row * 128 + c * 8);
    }
    __syncthreads();
    zero_acc(acc);
#pragma unroll
    for (int kk = 0; kk < 8; ++kk) {
      bf16x8 a[2], bq[2];
#pragma unroll
      for (int mi = 0; mi < 2; ++mi) a[mi] = *(const bf16x8*)(kss + swz256(wi * 64 + mi * 32 + r, kk * 2 + h));
#pragma unroll
      for (int nj = 0; nj < 2; ++nj) bq[nj] = *(const bf16x8*)(pqs + swz256(wj * 64 + nj * 32 + r, kk * 2 + h));
#pragma unroll
      for (int mi = 0; mi < 2; ++mi)
#pragma unroll
        for (int nj = 0; nj < 2; ++nj) acc[mi][nj] = MFMA32(a[mi], bq[nj], acc[mi][nj]);
    }
    __syncthreads();
    float* sc = (float*)smem;
#pragma unroll
    for (int mi = 0; mi < 2; ++mi)
#pragma unroll
      for (int nj = 0; nj < 2; ++nj)
#pragma unroll
        for (int reg = 0; reg < 16; ++reg)
          sc[(wi * 64 + mi * 32 + crow(reg, h)) * 128 + wj * 64 + nj * 32 + r] = acc[mi][nj][reg];
    __syncthreads();
    const int tok = tid & 127, half = tid >> 7;
    float v[16];
#pragma unroll
    for (int k = 0; k < 16; ++k) v[k] = -INFINITY;
    for (int n = half * 64; n < half * 64 + 64; ++n) {
      float xk = __uint_as_float((__float_as_uint(sc[n * 128 + tok]) & ~127u) | (unsigned)n);
#pragma unroll
      for (int k = 0; k < 16; ++k) {
        const float hi = fmaxf(v[k], xk);
        xk = fminf(v[k], xk);
        v[k] = hi;
      }
    }
    __syncthreads();
    if (half == 1) {
#pragma unroll
      for (int k = 0; k < 16; ++k) sc[k * 128 + tok] = v[k];
    }
    __syncthreads();
    if (half == 0) {
#pragma unroll
      for (int q = 0; q < 16; ++q) {
        float xk = sc[q * 128 + tok];
#pragma unroll
        for (int k = 0; k < 16; ++k) {
          const float hi = fmaxf(v[k], xk);
          xk = fminf(v[k], xk);
          v[k] = hi;
        }
      }
      unsigned* dst = P_TOPK + ((size_t)(j0 + tok) * 16 + it) * 16;
#pragma unroll
      for (int q = 0; q < 4; ++q)
        *(uint4*)(dst + 4 * q) = make_uint4(__float_as_uint(v[4 * q]), __float_as_uint(v[4 * q + 1]), __float_as_uint(v[4 * q + 2]),
                                            __float_as_uint(v[4 * q + 3]));
    }
    __syncthreads();
  }
}

DI float gelu_fast(float x) {
  const float z = 0.7978845608028654f * (x + 0.044715f * x * x * x);
  return x * __builtin_amdgcn_rcpf(1.f + exp2f(-2.f * LOG2E * z));
}
DI float gelu_tanh(float x) { return 0.5f * x * (1.f + tanhf(0.7978845608028654f * (x + 0.044715f * x * x * x))); }

DI void peer_batch_load(const Params& p, const int* se, const float* sg, int eb, int lane, u32x4 (&ur)[8], u32x2 (&vr)[8],
                        float& uis_my, float& vis_my, float& g_my) {
  const int myq = eb * 8 + (lane >> 3);
  const int e_my = se[myq];
  g_my = sg[myq];
  uis_my = P_UIS[e_my];
  vis_my = P_VIS[e_my];
#pragma unroll
  for (int q = 0; q < 8; ++q) {
    const int ei = __builtin_amdgcn_readfirstlane(se[eb * 8 + q]);
    ur[q] = *(const u32x4*)(P_U8 + (size_t)ei * 1024 + lane * 16);
    vr[q] = *(const u32x2*)(P_V8 + (size_t)ei * 512 + lane * 8);
  }
}
DI void peer_batch_compute(const u32x4 (&ur)[8], const u32x2 (&vr)[8], float uscale, float vis_my, float g_my, const int (&xq)[4],
                           f32x2 (&yv)[8], int lane) {
  const bool b5 = (lane & 32) != 0, b4 = (lane & 16) != 0, b3 = (lane & 8) != 0;
  float d[8];
#pragma unroll
  for (int q = 0; q < 8; ++q) {
    int a = 0;
#pragma unroll
    for (int k = 0; k < 4; ++k) a = __builtin_amdgcn_sdot4((int)ur[q][k], xq[k], a, false);
    d[q] = (float)a;
  }
  float t4[4], t2[2], t1;
#pragma unroll
  for (int i = 0; i < 4; ++i) {
    const float snd = b5 ? d[i] : d[i + 4], kp = b5 ? d[i + 4] : d[i];
    t4[i] = kp + __shfl_xor(snd, 32);
  }
#pragma unroll
  for (int i = 0; i < 2; ++i) {
    const float snd = b4 ? t4[i] : t4[i + 2], kp = b4 ? t4[i + 2] : t4[i];
    t2[i] = kp + __shfl_xor(snd, 16);
  }
  {
    const float snd = b3 ? t2[0] : t2[1], kp = b3 ? t2[1] : t2[0];
    t1 = kp + dpp_f<0x140>(snd);
  }
  t1 += dpp_f<0x141>(t1);
  t1 += dpp_f<0x4E>(t1);
  t1 += dpp_f<0xB1>(t1);
  const float wmy = g_my * gelu_fast(t1 * uscale) * vis_my;
#pragma unroll
  for (int q = 0; q < 8; ++q) {
    const float wq = __builtin_bit_cast(float, __builtin_amdgcn_readlane(__builtin_bit_cast(int, wmy), 8 * q));
    const f32x2 w2 = {wq, wq};
#pragma unroll
    for (int k = 0; k < 2; ++k) {
      yv[4 * k + 0] += w2 * __builtin_amdgcn_cvt_scalef32_pk_f32_fp4(vr[q][k], 1.0f, 0);
      yv[4 * k + 1] += w2 * __builtin_amdgcn_cvt_scalef32_pk_f32_fp4(vr[q][k], 1.0f, 1);
      yv[4 * k + 2] += w2 * __builtin_amdgcn_cvt_scalef32_pk_f32_fp4(vr[q][k], 1.0f, 2);
      yv[4 * k + 3] += w2 * __builtin_amdgcn_cvt_scalef32_pk_f32_fp4(vr[q][k], 1.0f, 3);
    }
  }
}

DI void phase_peer_final(const Params& p, int layer, char* smem) {
  const int tid = opaque_tid(), lane = tid & 63, w = tid >> 6;
  const int wave = (blockIdx.x * 256 + tid) >> 6, nw = gridDim.x * 4;
  int* se = (int*)(smem + w * 2048);
  float* sg = (float*)(smem + w * 2048 + 512);
  float* sr = (float*)(smem + w * 2048 + 1024);
  int ci, cj;
  if (lane < 16) { ci = 0; cj = lane; }
  else if (lane < 24) { ci = 1; cj = lane - 16; }
  else if (lane < 29) { ci = 2; cj = lane - 24; }
  else if (lane < 33) { ci = 3; cj = lane - 29; }
  else if (lane < 36) { ci = 4; cj = lane - 33; }
  else if (lane < 42) { ci = 5 + ((lane - 36) >> 1); cj = (lane - 36) & 1; }
  else if (lane < 50) { ci = 8 + (lane - 42); cj = 0; }
  else { ci = 0; cj = 0; }
  const int ntok = (layer == 0) ? NTOK : 4 * 8192;
  u32x4 cx0, cx1;
  unsigned ck1[8], ck2[8];
  {
    const int idx0 = min(wave, ntok - 1);
    const int u0 = (layer == 0) ? idx0 : (idx0 >> 13) * LKB + 256 + (idx0 & 8191);
    cx0 = *(const u32x4*)(P_H + (size_t)u0 * 1024 + lane * 16);
    cx1 = *(const u32x4*)(P_H + (size_t)u0 * 1024 + lane * 16 + 8);
#pragma unroll
    for (int hd = 0; hd < 8; ++hd) {
      const unsigned* tk = P_TOPK + ((size_t)u0 * 8 + hd) * 32;
      ck1[hd] = tk[ci];
      ck2[hd] = tk[16 + cj];
    }
  }
  for (int idx = wave; idx < ntok; idx += nw) {
    const int u = (layer == 0) ? idx : (idx >> 13) * LKB + 256 + (idx & 8191);
    const int b = u / LKB, pp = u - b * LKB;
    const bool isctx = pp < 256;
    float xf[16];
    {
      xf[0] = bf_lo(cx0.x); xf[1] = bf_hi(cx0.x); xf[2] = bf_lo(cx0.y); xf[3] = bf_hi(cx0.y);
      xf[4] = bf_lo(cx0.z); xf[5] = bf_hi(cx0.z); xf[6] = bf_lo(cx0.w); xf[7] = bf_hi(cx0.w);
      xf[8] = bf_lo(cx1.x); xf[9] = bf_hi(cx1.x); xf[10] = bf_lo(cx1.y); xf[11] = bf_hi(cx1.y);
      xf[12] = bf_lo(cx1.z); xf[13] = bf_hi(cx1.z); xf[14] = bf_lo(cx1.w); xf[15] = bf_hi(cx1.w);
    }
    float xmx = 0.f;
#pragma unroll
    for (int i = 0; i < 16; ++i) xmx = fmaxf(xmx, fabsf(xf[i]));
    xmx = wave_max(xmx);
    const float xsc = (xmx > 1e-30f) ? 127.f / xmx : 1.f;
    const float x_inv = (xmx > 1e-30f) ? xmx * (1.f / 127.f) : 1.f;
    int xq[4];
#pragma unroll
    for (int k = 0; k < 4; ++k)
      xq[k] = (int)(((unsigned)__float2int_rn(xf[4 * k] * xsc) & 255u) | (((unsigned)__float2int_rn(xf[4 * k + 1] * xsc) & 255u) << 8) |
                    (((unsigned)__float2int_rn(xf[4 * k + 2] * xsc) & 255u) << 16) | (((unsigned)__float2int_rn(xf[4 * k + 3] * xsc) & 255u) << 24));
    unsigned* sru = (unsigned*)sr;
#pragma unroll
    for (int hd = 0; hd < 8; ++hd) {
      const unsigned k1 = ck1[hd], k2 = ck2[hd];
      const float s = __uint_as_float(k1) + __uint_as_float(k2);
      const int e = (int)((k1 & 127u) * 128u + (k2 & 127u));
      unsigned ob = __float_as_uint(s);
      ob ^= (ob & 0x80000000u) ? 0xffffffffu : 0x80000000u;
      const unsigned key = (lane < 50) ? ((ob & ~63u) | (unsigned)(63 - lane)) : 0u;
      sru[lane] = key;
      __builtin_amdgcn_wave_barrier();
      int rank = 0;
#pragma unroll
      for (int L4 = 0; L4 < 13; ++L4) {
        const u32x4 q4 = *(const u32x4*)(sru + 4 * L4);
        rank += (q4.x > key) ? 1 : 0;
        rank += (q4.y > key) ? 1 : 0;
        rank += (q4.z > key) ? 1 : 0;
        rank += (q4.w > key) ? 1 : 0;
      }
      __builtin_amdgcn_wave_barrier();
      if ((lane < 50) && (rank < 16)) { se[hd * 16 + rank] = e; sg[hd * 16 + rank] = s; }
    }
    __builtin_amdgcn_wave_barrier();
#pragma unroll
    for (int j = 0; j < 2; ++j) {
      const int idx = lane + 64 * j;
      const float sv = sg[idx], m0 = sg[idx & ~15];
      const float ex = exp2f((sv - m0) * LOG2E);
      float sm = ex;
      sm += __shfl_xor(sm, 1); sm += __shfl_xor(sm, 2); sm += __shfl_xor(sm, 4); sm += __shfl_xor(sm, 8);
      __builtin_amdgcn_wave_barrier();
      sg[idx] = ex * __builtin_amdgcn_rcpf(sm);
    }
    __builtin_amdgcn_wave_barrier();
    f32x2 xv[8], yv[8];
#pragma unroll
    for (int i = 0; i < 8; ++i) { xv[i].x = xf[2 * i]; xv[i].y = xf[2 * i + 1]; yv[i].x = 0.f; yv[i].y = 0.f; }
    const bool b5 = (lane & 32) != 0, b4 = (lane & 16) != 0, b3 = (lane & 8) != 0;
    {
      const int idxn = min(idx + nw, ntok - 1);
      const int un = (layer == 0) ? idxn : (idxn >> 13) * LKB + 256 + (idxn & 8191);
      cx0 = *(const u32x4*)(P_H + (size_t)un * 1024 + lane * 16);
      cx1 = *(const u32x4*)(P_H + (size_t)un * 1024 + lane * 16 + 8);
#pragma unroll
      for (int hd = 0; hd < 8; ++hd) {
        const unsigned* tk = P_TOPK + ((size_t)un * 8 + hd) * 32;
        ck1[hd] = tk[ci];
        ck2[hd] = tk[16 + cj];
      }
    }
    const int mr = isctx ? 4 : b;
    const float* gate = P_MOD + (layer * 5 + mr) * 6144 + 5 * 1024;
    const float* rsrc = P_R + (size_t)u * 1024;
    float4 rv4[4], gv4[4];
#pragma unroll
    for (int q = 0; q < 4; ++q) {
      rv4[q] = *(const float4*)(rsrc + lane * 16 + q * 4);
      gv4[q] = *(const float4*)(gate + lane * 16 + q * 4);
    }
    {
      u32x4 urA[8], urB[8];
      u32x2 vrA[8], vrB[8];
      float sA, vA, gA, sB, vB, gB;
      peer_batch_load(p, se, sg, 0, lane, urA, vrA, sA, vA, gA);
#pragma unroll 1
      for (int eb = 0; eb < 16; eb += 2) {
        peer_batch_load(p, se, sg, eb + 1, lane, urB, vrB, sB, vB, gB);
        __builtin_amdgcn_sched_barrier(0);
        peer_batch_compute(urA, vrA, sA * x_inv, vA, gA, xq, yv, lane);
        peer_batch_load(p, se, sg, min(eb + 2, 15), lane, urA, vrA, sA, vA, gA);
        __builtin_amdgcn_sched_barrier(0);
        peer_batch_compute(urB, vrB, sB * x_inv, vB, gB, xq, yv, lane);
      }
    }
    float y[16];
#pragma unroll
    for (int i = 0; i < 8; ++i) { y[2 * i] = yv[i].x; y[2 * i + 1] = yv[i].y; }
    __builtin_amdgcn_wave_barrier();
    float* dst = (layer == 0) ? P_R + (size_t)u * 1024 : p.out + ((size_t)b * 8192 + (pp - 256)) * 1024;
    float4 ov[4];
    float ss = 0.f;
#pragma unroll
    for (int q = 0; q < 4; ++q) {
      const int col = lane * 16 + q * 4;
      const float4 rv = rv4[q];
      const float4 gv = gv4[q];
      float4 o;
      o.x = rv.x + gv.x * y[q * 4 + 0];
      o.y = rv.y + gv.y * y[q * 4 + 1];
      o.z = rv.z + gv.z * y[q * 4 + 2];
      o.w = rv.w + gv.w * y[q * 4 + 3];
      *(float4*)(dst + col) = o;
      ov[q] = o;
      ss += o.x * o.x + o.y * o.y + o.z * o.z + o.w * o.w;
    }
    if (layer == 0) {
      ss = wave_sum(ss);
      const float rn = rsqrtf(ss * (1.f / 1024.f) + 1e-6f);
      const float* g1 = p.norm_g + 2 * 1024;
      const float* shift = P_MOD + (5 + mr) * 6144;
      const float* scale = shift + 1024;
#pragma unroll
      for (int q = 0; q < 4; ++q) {
        const int col = lane * 16 + q * 4;
        const float4 g4 = *(const float4*)(g1 + col), sc = *(const float4*)(scale + col), sh = *(const float4*)(shift + col);
        const float y0 = ov[q].x * rn * g4.x * (1.f + sc.x) + sh.x;
        const float y1 = ov[q].y * rn * g4.y * (1.f + sc.y) + sh.y;
        const float y2 = ov[q].z * rn * g4.z * (1.f + sc.z) + sh.z;
        const float y3 = ov[q].w * rn * g4.w * (1.f + sc.w) + sh.w;
        *(uint2*)(P_H + (size_t)u * 1024 + col) = make_uint2(pack2(y0, y1), pack2(y2, y3));
      }
    }
  }
}

__global__ void __launch_bounds__(256, 2) fwd_mega(Params p) {
  cg::grid_group grid = cg::this_grid();
  __shared__ __attribute__((aligned(16))) char smem[SMEM_BYTES];
  volatile LAS unsigned* xb_st = (volatile LAS unsigned*)(smem + SMEM_BYTES - 16);
  if (threadIdx.x == 0) { xb_st[0] = 0u; xb_st[1] = 0u; }
  __syncthreads();
  const XcdBarrier xb = xcd_barrier_post(P_BAR, xb_st);
  phase_prologue(p, smem);
  xcd_barrier(xb);
  if (p.out == nullptr) grid.sync();
  for (int layer = 0; layer < 2; ++layer) {
    if (layer == 0) {
      phase_norm(p, 0, 0);
      xcd_barrier(xb);
    }
    phase_qkv(p, layer, smem);
    xcd_barrier(xb);
    if (layer == 0) phase_attn_l0(p, smem); else phase_attn_l1(p, smem);
    xcd_barrier(xb);
    phase_outproj(p, layer, smem);
    convert_i8_rows(p.peer_u + (size_t)layer * 16384 * 1024, P_U8, P_UIS);
    convert_fp4_rows(p.peer_v + (size_t)layer * 16384 * 1024, P_V8, P_VIS);
    xcd_barrier(xb);
    phase_norm(p, layer, 1);
    xcd_barrier(xb);
    phase_peerq(p, layer, smem);
    xcd_barrier(xb);
    phase_peer_final(p, layer, smem);
    if (layer == 0) xcd_barrier(xb);
  }
}

extern "C" void kernel_launch(void* const* d_in, const int* in_sizes, int n_in, void* d_out, int out_size, void* d_ws,
                              size_t ws_size, hipStream_t stream) {
  static int grid_blocks = 0;
  if (!grid_blocks) {
    int dev = 0, cus = 0, per_cu = 0;
    (void)hipGetDevice(&dev);
    (void)hipDeviceGetAttribute(&cus, hipDeviceAttributeMultiprocessorCount, dev);
    (void)hipOccupancyMaxActiveBlocksPerMultiprocessor(&per_cu, fwd_mega, 256, 0);
    if (per_cu > 2) per_cu = 2;
    if (per_cu < 1) per_cu = 1;
    grid_blocks = cus * per_cu;
    grid_blocks &= ~7;
  }
  Params p{};
  const float* const* in = (const float* const*)d_in;
  p.x = in[0]; p.c = in[1]; p.ctx = in[2]; p.c_ctx = in[3]; p.ada_w = in[4]; p.ada_b = in[5]; p.norm_g = in[6];
  p.ab_w_in = in[7]; p.ab_w_out = in[8]; p.a_qn = in[9]; p.a_kn = in[10]; p.b_qn = in[11]; p.b_kn = in[12]; p.b_lam = in[13];
  p.b_subln = in[14]; p.c_w_in = in[15]; p.c_w_out = in[16]; p.c_qn = in[17]; p.c_kn = in[18]; p.c_rpb = in[19];
  p.peer_wq = in[20]; p.peer_keys = in[21]; p.peer_u = in[22]; p.peer_v = in[23];
  p.out = (float*)d_out;
  p.ws = (char*)d_ws;
  if (WS_TOTAL > ws_size) { fprintf(stderr, "workspace too small: need %zu have %zu\n", (size_t)WS_TOTAL, ws_size); return; }
  (void)hipMemsetAsync((char*)d_ws + OFF_BAR, 0, 16384, stream);
  void* args[] = {&p};
  hipError_t e = hipLaunchCooperativeKernel((void*)fwd_mega, dim3(grid_blocks), dim3(256), args, 0, stream);
  if (e != hipSuccess) fprintf(stderr, "cooperative launch failed: %s (grid %d)\n", hipGetErrorString(e), grid_blocks);
}
```

```cpp
#include <hip/hip_runtime.h>
#include <hip/hip_cooperative_groups.h>
#include <cstdio>
namespace cg = cooperative_groups;

#define DI __device__ __forceinline__
typedef unsigned short ushort_t;
using bf16x8 = __attribute__((ext_vector_type(8))) short;
using f32x16 = __attribute__((ext_vector_type(16))) float;
using u32x4 = __attribute__((ext_vector_type(4))) unsigned;
using f32x2 = __attribute__((ext_vector_type(2))) float;
using u32x2 = __attribute__((ext_vector_type(2))) unsigned;
#define MFMA32(a, b, c) __builtin_amdgcn_mfma_f32_32x32x16_bf16((a), (b), (c), 0, 0, 0)

constexpr int DM = 1024;
constexpr int LKB = 8448;
constexpr int NTOK = 4 * LKB;
constexpr int SMEM_BYTES = 66560;
constexpr float LOG2E = 1.4426950408889634f;

struct Params {
  const float *x, *c, *ctx, *c_ctx, *ada_w, *ada_b, *norm_g, *ab_w_in, *ab_w_out, *a_qn, *a_kn, *b_qn, *b_kn, *b_lam,
      *b_subln, *c_w_in, *c_w_out, *c_qn, *c_kn, *c_rpb, *peer_wq, *peer_keys, *peer_u, *peer_v;
  float* out;
  char* ws;
};
constexpr size_t al256(size_t x) { return (x + 255) & ~(size_t)255; }
constexpr size_t OFF_MOD = 0;
constexpr size_t OFF_SCAL = OFF_MOD + al256(2 * 5 * 6144 * 4);
constexpr size_t OFF_BAR = OFF_SCAL + 256;
constexpr size_t OFF_ROPE = OFF_BAR + 16384;
constexpr size_t OFF_WABIN = OFF_ROPE + al256(128 * 16 * 8);
constexpr size_t OFF_WABOUT = OFF_WABIN + (size_t)2304 * 1024 * 2;
constexpr size_t OFF_WCIN = OFF_WABOUT + (size_t)1024 * 1024 * 2;
constexpr size_t OFF_WCOUT = OFF_WCIN + (size_t)3072 * 1024 * 2;
constexpr size_t OFF_WPQ = OFF_WCOUT + (size_t)1024 * 1024 * 2;
constexpr size_t OFF_KEYS = OFF_WPQ + (size_t)2 * 2048 * 1024 * 2;
constexpr size_t OFF_H = OFF_KEYS + (size_t)2 * 8 * 2 * 128 * 128 * 2;
constexpr size_t OFF_QB = OFF_H + (size_t)NTOK * 1024 * 2;
constexpr size_t OFF_KB = OFF_QB + (size_t)NTOK * 1024 * 2;
constexpr size_t OFF_VT = OFF_KB + (size_t)NTOK * 1024 * 2;
constexpr size_t OFF_R = OFF_VT + (size_t)NTOK * 1024 * 2;
constexpr size_t WS_TOTAL = OFF_R + (size_t)NTOK * 1024 * 4;
#define P_MOD ((float*)(p.ws + OFF_MOD))
#define P_SCAL ((float*)(p.ws + OFF_SCAL))
#define P_ROPE ((float2*)(p.ws + OFF_ROPE))
#define P_WABIN ((ushort_t*)(p.ws + OFF_WABIN))
#define P_WABOUT ((ushort_t*)(p.ws + OFF_WABOUT))
#define P_WCIN ((ushort_t*)(p.ws + OFF_WCIN))
#define P_WCOUT ((ushort_t*)(p.ws + OFF_WCOUT))
#define P_WPQ ((ushort_t*)(p.ws + OFF_WPQ))
#define P_KEYS ((ushort_t*)(p.ws + OFF_KEYS))
#define P_H ((ushort_t*)(p.ws + OFF_H))
#define P_QB ((ushort_t*)(p.ws + OFF_QB))
#define P_KB ((ushort_t*)(p.ws + OFF_KB))
#define P_VT ((ushort_t*)(p.ws + OFF_VT))
#define P_R ((float*)(p.ws + OFF_R))
#define P_U8 ((unsigned char*)(p.ws + OFF_QB))
#define P_V8 ((unsigned char*)(p.ws + OFF_QB) + (size_t)16384 * 1024)
#define P_UIS ((float*)(p.ws + OFF_QB + (size_t)2 * 16384 * 1024))
#define P_VIS ((float*)(p.ws + OFF_QB + (size_t)2 * 16384 * 1024 + 65536))
#define P_BAR ((unsigned*)(p.ws + OFF_BAR))
#define P_TOPK ((unsigned*)(p.ws + OFF_KB))

DI int opaque_tid() { int t = threadIdx.x; asm volatile("" : "+v"(t)); return t; }
DI float bf_lo(unsigned u) { return __uint_as_float(u << 16); }
DI float bf_hi(unsigned u) { return __uint_as_float(u & 0xffff0000u); }
DI unsigned pack2(float a, float b) {
  typedef __bf16 bf2_t __attribute__((ext_vector_type(2)));
  typedef float f2_t __attribute__((ext_vector_type(2)));
  f2_t v = {a, b};
  bf2_t r = __builtin_convertvector(v, bf2_t);
  return __builtin_bit_cast(unsigned, r);
}
DI ushort_t tobf(float a) { return (ushort_t)(pack2(a, 0.f) & 0xffffu); }
DI int crow(int reg, int h) { return (reg & 3) + 8 * (reg >> 2) + 4 * h; }
DI int swz128(int row, int chunk) { return row * 128 + ((chunk ^ ((row >> 1) & 7)) << 4); }
DI int swz256(int row, int chunk) { return row * 256 + ((chunk ^ (row & 15)) << 4); }
template <int CTRL>
DI float dpp_f(float v) {
  return __builtin_bit_cast(float, __builtin_amdgcn_update_dpp(0, __builtin_bit_cast(int, v), CTRL, 0xf, 0xf, false));
}
DI float wave_sum(float v) {
#pragma unroll
  for (int o = 32; o >= 1; o >>= 1) v += __shfl_xor(v, o);
  return v;
}
DI float wave_max(float v) {
#pragma unroll
  for (int o = 32; o >= 1; o >>= 1) v = fmaxf(v, __shfl_xor(v, o));
  return v;
}

#define XB_TMO      128
#define XB_XCNT(j)  (256  + 64 * (j))
#define XB_XSUB(j)  (1280 + 64 * (j))
#define XB_XGEN(j)  (2304 + 64 * (j))
#define XB_TOP      3328
#define XB_TOPGEN   3392
#define XCD_BAR_WORDS 3456
#define XB_SPIN_CAP (1u << 22)
#define LAS __attribute__((address_space(3)))
DI unsigned xb_ld(unsigned* p) { return __hip_atomic_load(p, __ATOMIC_RELAXED, __HIP_MEMORY_SCOPE_AGENT); }
DI unsigned xb_add(unsigned* p, unsigned v) { return __hip_atomic_fetch_add(p, v, __ATOMIC_RELAXED, __HIP_MEMORY_SCOPE_AGENT); }
DI unsigned xb_xcc_id() { return (unsigned)__builtin_amdgcn_s_getreg((3 << 11) | 20) & 0xFu; }
#define XB_SPIN(cond, bar) do { unsigned _sp = 0; while (cond) { __builtin_amdgcn_s_sleep(1); \
    if ((++_sp & 255u) == 0u) { if (xb_ld(&(bar)[XB_TMO])) break; if (_sp > XB_SPIN_CAP) { atomicAdd(&(bar)[XB_TMO], 1u); break; } } } } while (0)
struct XcdBarrier { unsigned* bar; unsigned x; volatile LAS unsigned* st; };
DI XcdBarrier xcd_barrier_post(unsigned* bar, volatile LAS unsigned* st) {
  XcdBarrier b; b.bar = bar; b.x = xb_xcc_id(); b.st = st;
  if (threadIdx.x == 0) (void)xb_add(&bar[XB_XCNT(b.x)], 1u);
  return b;
}
DI void xcd_barrier_complete(unsigned* bar, unsigned x, unsigned& nloc, unsigned& nx) {
  const unsigned G = gridDim.x;
  unsigned sum, cnt, mine, sp = 0u;
  for (;;) {
    sum = 0u; cnt = 0u; mine = 0u;
#pragma unroll
    for (unsigned j = 0; j < 16; ++j) { const unsigned c = xb_ld(&bar[XB_XCNT(j)]); sum += c; cnt += (c > 0u) ? 1u : 0u; mine = (j == x) ? c : mine; }
    if (sum == G) break;
    __builtin_amdgcn_s_sleep(1);
    if ((++sp & 255u) == 0u) { if (xb_ld(&bar[XB_TMO])) break; if (sp > XB_SPIN_CAP) { atomicAdd(&bar[XB_TMO], 1u); break; } }
  }
  nloc = mine > 0u ? mine : 1u; nx = cnt > 0u ? cnt : 1u;
}
DI void xcd_barrier(const XcdBarrier& b) {
  asm volatile("s_waitcnt vmcnt(0)" ::: "memory");
  __syncthreads();
  if (threadIdx.x == 0) {
    unsigned* bar = b.bar;
    __builtin_amdgcn_s_waitcnt(0);
    unsigned nloc = b.st[0], nx = b.st[1];
    if (nloc == 0u) { xcd_barrier_complete(bar, b.x, nloc, nx); b.st[0] = nloc; b.st[1] = nx; }
    const unsigned old = xb_add(&bar[XB_XSUB(b.x)], 1u);
    const unsigned gen = old / nloc;
    if (old + 1u == (gen + 1u) * nloc) {
      __builtin_amdgcn_fence(__ATOMIC_RELEASE, "agent");
      asm volatile("s_waitcnt vmcnt(0)" ::: "memory");
      const unsigned og = xb_add(&bar[XB_TOP], 1u);
      const unsigned tg = og / nx;
      if (og + 1u == (tg + 1u) * nx) xb_add(&bar[XB_TOPGEN], 1u);
      else XB_SPIN(xb_ld(&bar[XB_TOPGEN]) == tg, bar);
      __builtin_amdgcn_fence(__ATOMIC_ACQUIRE, "agent");
      xb_add(&bar[XB_XGEN(b.x)], 1u);
      asm volatile("s_waitcnt vmcnt(0)" ::: "memory");
    } else {
      XB_SPIN(xb_ld(&bar[XB_XGEN(b.x)]) == gen, bar);
      __builtin_amdgcn_fence(__ATOMIC_ACQUIRE, "agent");
      asm volatile("s_waitcnt vmcnt(0)" ::: "memory");
    }
  }
  __syncthreads();
}

DI void convert_i8_rows(const float* __restrict__ src, unsigned char* __restrict__ dst, float* __restrict__ inv_scale) {
  const int tid = opaque_tid();
  const int lane = tid & 63;
  const int wave = (blockIdx.x * 256 + tid) >> 6, nw = gridDim.x * 4;
  for (int row = wave; row < 16384; row += nw) {
    float4 v[4];
    float mx = 0.f;
#pragma unroll
    for (int i = 0; i < 4; ++i) {
      v[i] = *(const float4*)(src + (size_t)row * 1024 + i * 256 + lane * 4);
      mx = fmaxf(mx, fmaxf(fmaxf(fabsf(v[i].x), fabsf(v[i].y)), fmaxf(fabsf(v[i].z), fabsf(v[i].w))));
    }
    mx = wave_max(mx);
    const float sc = (mx > 1e-30f) ? 127.f / mx : 1.f;
#pragma unroll
    for (int i = 0; i < 4; ++i) {
      const unsigned w = ((unsigned)__float2int_rn(v[i].x * sc) & 255u) | (((unsigned)__float2int_rn(v[i].y * sc) & 255u) << 8) |
                         (((unsigned)__float2int_rn(v[i].z * sc) & 255u) << 16) | (((unsigned)__float2int_rn(v[i].w * sc) & 255u) << 24);
      *(unsigned*)(dst + (size_t)row * 1024 + i * 256 + lane * 4) = w;
    }
    if (lane == 0) inv_scale[row] = (mx > 1e-30f) ? mx * (1.f / 127.f) : 1.f;
  }
}

DI void convert_fp4_rows(const float* __restrict__ src, unsigned char* __restrict__ dst, float* __restrict__ inv_scale) {
  const int tid = opaque_tid();
  const int lane = tid & 63;
  const int wave = (blockIdx.x * 256 + tid) >> 6, nw = gridDim.x * 4;
  for (int row = wave; row < 16384; row += nw) {
    float4 v[4];
    float mx = 0.f;
#pragma unroll
    for (int i = 0; i < 4; ++i) {
      v[i] = *(const float4*)(src + (size_t)row * 1024 + (i >> 1) * 512 + lane * 8 + (i & 1) * 4);
      mx = fmaxf(mx, fmaxf(fmaxf(fabsf(v[i].x), fabsf(v[i].y)), fmaxf(fabsf(v[i].z), fabsf(v[i].w))));
    }
    mx = wave_max(mx);
    const float sc = (mx > 1e-30f) ? 6.f / mx : 1.f;
#pragma unroll
    for (int ps = 0; ps < 2; ++ps) {
      unsigned w = 0u;
      w = __builtin_amdgcn_cvt_scalef32_pk_fp4_f32(w, v[2 * ps].x * sc, v[2 * ps].y * sc, 1.0f, 0);
      w = __builtin_amdgcn_cvt_scalef32_pk_fp4_f32(w, v[2 * ps].z * sc, v[2 * ps].w * sc, 1.0f, 1);
      w = __builtin_amdgcn_cvt_scalef32_pk_fp4_f32(w, v[2 * ps + 1].x * sc, v[2 * ps + 1].y * sc, 1.0f, 2);
      w = __builtin_amdgcn_cvt_scalef32_pk_fp4_f32(w, v[2 * ps + 1].z * sc, v[2 * ps + 1].w * sc, 1.0f, 3);
      *(unsigned*)(dst + (size_t)row * 512 + ps * 256 + lane * 4) = w;
    }
    if (lane == 0) inv_scale[row] = (mx > 1e-30f) ? mx * (1.f / 6.f) : 1.f;
  }
}

DI void transpose_convert(const float* __restrict__ src, ushort_t* __restrict__ dst, int K, int N, float* tile) {
  const int tid = opaque_tid();
  const int tilesN = N / 64, nt = tilesN * (K / 64);
  for (int t = blockIdx.x; t < nt; t += gridDim.x) {
    const int k0 = (t / tilesN) * 64, n0 = (t % tilesN) * 64;
#pragma unroll
    for (int ps = 0; ps < 4; ++ps) {
      const int r = ps * 16 + (tid >> 4), c4 = (tid & 15) * 4;
      const float4 v = *(const float4*)(src + (size_t)(k0 + r) * N + n0 + c4);
      tile[r * 65 + c4 + 0] = v.x; tile[r * 65 + c4 + 1] = v.y; tile[r * 65 + c4 + 2] = v.z; tile[r * 65 + c4 + 3] = v.w;
    }
    __syncthreads();
    const int n = tid >> 2, kc = (tid & 3) * 16;
    unsigned w[8];
#pragma unroll
    for (int i = 0; i < 8; ++i) w[i] = pack2(tile[(kc + 2 * i) * 65 + n], tile[(kc + 2 * i + 1) * 65 + n]);
    uint4* d = (uint4*)(dst + (size_t)(n0 + n) * K + k0 + kc);
    d[0] = make_uint4(w[0], w[1], w[2], w[3]);
    d[1] = make_uint4(w[4], w[5], w[6], w[7]);
    __syncthreads();
  }
}

DI void convert_flat(const float* __restrict__ src, ushort_t* __restrict__ dst, size_t n4) {
  const size_t gt = (size_t)blockIdx.x * 256 + opaque_tid(), gs = (size_t)gridDim.x * 256;
  for (size_t i = gt; i < n4; i += gs) {
    const float4 v = ((const float4*)src)[i];
    ((uint2*)dst)[i] = make_uint2(pack2(v.x, v.y), pack2(v.z, v.w));
  }
}

DI void phase_prologue(const Params& p, char* smem) {
  const int tid = opaque_tid();
  float* sl = (float*)smem;
  float* red = sl + 5 * 1024;
  for (int item = blockIdx.x; item < 192; item += gridDim.x) {
    const int l = item / 96, n0 = (item % 96) * 64;
    for (int i = tid; i < 5 * 1024; i += 256) {
      const int r = i >> 10, k = i & 1023;
      const float v = (r < 4) ? p.c[r * 1024 + k] : p.c_ctx[k];
      sl[i] = v / (1.f + expf(-v));
    }
    __syncthreads();
    const int kg = tid >> 6, col = tid & 63;
    float a0 = 0, a1 = 0, a2 = 0, a3 = 0, a4 = 0;
    const float* w = p.ada_w + (size_t)l * 1024 * 6144 + n0 + col;
#pragma unroll 8
    for (int k = kg * 256; k < kg * 256 + 256; ++k) {
      const float wv = w[(size_t)k * 6144];
      a0 += sl[k] * wv; a1 += sl[1024 + k] * wv; a2 += sl[2048 + k] * wv; a3 += sl[3072 + k] * wv; a4 += sl[4096 + k] * wv;
    }
    red[(kg * 5 + 0) * 64 + col] = a0; red[(kg * 5 + 1) * 64 + col] = a1; red[(kg * 5 + 2) * 64 + col] = a2;
    red[(kg * 5 + 3) * 64 + col] = a3; red[(kg * 5 + 4) * 64 + col] = a4;
    __syncthreads();
    for (int i = tid; i < 320; i += 256) {
      const int r = i >> 6, cc = i & 63;
      const float s = red[(0 * 5 + r) * 64 + cc] + red[(1 * 5 + r) * 64 + cc] + red[(2 * 5 + r) * 64 + cc] + red[(3 * 5 + r) * 64 + cc];
      P_MOD[(l * 5 + r) * 6144 + n0 + cc] = s + p.ada_b[l * 6144 + n0 + cc];
    }
    __syncthreads();
  }
  float* tile = (float*)smem;
  transpose_convert(p.ab_w_in, P_WABIN, 1024, 2304, tile);
  transpose_convert(p.ab_w_out, P_WABOUT, 1024, 1024, tile);
  transpose_convert(p.c_w_in, P_WCIN, 1024, 3072, tile);
  transpose_convert(p.c_w_out, P_WCOUT, 1024, 1024, tile);
  transpose_convert(p.peer_wq, P_WPQ, 1024, 2048, tile);
  transpose_convert(p.peer_wq + (size_t)1024 * 2048, P_WPQ + (size_t)2048 * 1024, 1024, 2048, tile);
  convert_flat(p.peer_keys, P_KEYS, (size_t)2 * 8 * 2 * 128 * 128 / 4);
  const int gt = blockIdx.x * 256 + tid;
  if (gt < 128 * 16) {
    const int pos = gt >> 4, fi = gt & 15;
    const float freq = 1.0f / powf(10000.f, (float)(2 * fi) / 32.f);
    const float ang = (float)pos * freq;
    P_ROPE[gt] = make_float2(cosf(ang), sinf(ang));
  }
  if (blockIdx.x == gridDim.x - 1) {
    float* rb = (float*)smem;
    float mv[8];
    const float* gv[6] = {p.a_qn, p.a_kn, p.b_qn, p.b_kn, p.c_qn, p.c_kn};
#pragma unroll
    for (int k = 0; k < 6; ++k) mv[k] = (tid < 64) ? fabsf(gv[k][tid]) : 0.f;
    float mr = 0.f;
    for (int i = tid; i < 16 * 465; i += 256) mr = fmaxf(mr, fabsf(p.c_rpb[i]));
    mv[6] = mr; mv[7] = 0.f;
    __syncthreads();
#pragma unroll
    for (int k = 0; k < 8; ++k) rb[k * 256 + tid] = mv[k];
    __syncthreads();
    if (tid < 8) {
      float mxv = 0.f;
      for (int i = 0; i < 256; ++i) mxv = fmaxf(mxv, rb[tid * 256 + i]);
      rb[2048 + tid] = mxv;
    }
    __syncthreads();
    if (tid == 0) {
      const float c8 = 8.f * LOG2E;
      P_SCAL[1] = c8 * rb[2048 + 0] * rb[2048 + 1];
      P_SCAL[2] = c8 * rb[2048 + 2] * rb[2048 + 3];
      P_SCAL[3] = c8 * rb[2048 + 4] * rb[2048 + 5] + LOG2E * rb[2048 + 6];
    }
    __syncthreads();
  }
  if (gt == 0) {
    float s1 = 0, s2 = 0;
    for (int i = 0; i < 64; ++i) { s1 += p.b_lam[i] * p.b_lam[64 + i]; s2 += p.b_lam[128 + i] * p.b_lam[192 + i]; }
    P_SCAL[0] = expf(s1) - expf(s2) + 0.2f;
  }
}

DI float wave_sum_dpp(float v) {
  v += dpp_f<0xB1>(v); v += dpp_f<0x4E>(v); v += dpp_f<0x141>(v); v += dpp_f<0x140>(v);
  v += __shfl_xor(v, 16);
  v += __shfl_xor(v, 32);
  return v;
}
DI const float* norm_src_row(const Params& p, int layer, int which, int u) {
  const int b = u / LKB, pp = u - b * LKB;
  if (layer == 0 && which == 0) return (pp < 256) ? p.ctx + ((size_t)b * 256 + pp) * 1024 : p.x + ((size_t)b * 8192 + (pp - 256)) * 1024;
  return P_R + (size_t)u * 1024;
}
DI void phase_norm(const Params& p, int layer, int which) {
  const int tid = opaque_tid();
  const int lane = tid & 63;
  const int wave = (blockIdx.x * 256 + tid) >> 6, nw = gridDim.x * 4;
  const float* g = p.norm_g + (layer * 2 + which) * 1024;
  const bool skipctx = (layer == 1 && which == 1);
  const int ntok = skipctx ? 4 * 8192 : NTOK;
  float4 nv[4];
  {
    const int idx0 = min(wave, ntok - 1);
    const int u0 = skipctx ? (idx0 >> 13) * LKB + 256 + (idx0 & 8191) : idx0;
    const float* s0 = norm_src_row(p, layer, which, u0);
#pragma unroll
    for (int i = 0; i < 4; ++i) nv[i] = *(const float4*)(s0 + i * 256 + lane * 4);
  }
  for (int idx = wave; idx < ntok; idx += nw) {
    const int u = skipctx ? (idx >> 13) * LKB + 256 + (idx & 8191) : idx;
    const int b = u / LKB, pp = u - b * LKB;
    const bool isctx = pp < 256;
    const int mr = isctx ? 4 : b;
    const float* shift = P_MOD + (layer * 5 + mr) * 6144 + (which ? 3 : 0) * 1024;
    const float* scale = shift + 1024;
    float4 v[4];
#pragma unroll
    for (int i = 0; i < 4; ++i) v[i] = nv[i];
    {
      const int idxn = min(idx + nw, ntok - 1);
      const int un = skipctx ? (idxn >> 13) * LKB + 256 + (idxn & 8191) : idxn;
      const float* sn = norm_src_row(p, layer, which, un);
#pragma unroll
      for (int i = 0; i < 4; ++i) nv[i] = *(const float4*)(sn + i * 256 + lane * 4);
    }
    __builtin_amdgcn_sched_barrier(0);
    float ss = 0.f;
#pragma unroll
    for (int i = 0; i < 4; ++i) ss += v[i].x * v[i].x + v[i].y * v[i].y + v[i].z * v[i].z + v[i].w * v[i].w;
    ss = wave_sum_dpp(ss);
    const float rn = rsqrtf(ss * (1.f / 1024.f) + 1e-6f);
#pragma unroll
    for (int i = 0; i < 4; ++i) {
      const int col = i * 256 + lane * 4;
      const float4 g4 = *(const float4*)(g + col), sc = *(const float4*)(scale + col), sh = *(const float4*)(shift + col);
      const float y0 = v[i].x * rn * g4.x * (1.f + sc.x) + sh.x;
      const float y1 = v[i].y * rn * g4.y * (1.f + sc.y) + sh.y;
      const float y2 = v[i].z * rn * g4.z * (1.f + sc.z) + sh.z;
      const float y3 = v[i].w * rn * g4.w * (1.f + sc.w) + sh.w;
      *(uint2*)(P_H + (size_t)u * 1024 + col) = make_uint2(pack2(y0, y1), pack2(y2, y3));
    }
  }
}

DI void gemm_load(const ushort_t* __restrict__ P, const ushort_t* __restrict__ Q, int kt, int srow, int sch, u32x4 (&pr)[4], u32x4 (&qr)[4]) {
#pragma unroll
  for (int ps = 0; ps < 4; ++ps) {
    pr[ps] = *(const u32x4*)(P + (size_t)(srow + 32 * ps) * 1024 + kt * 64 + sch * 8);
    qr[ps] = *(const u32x4*)(Q + (size_t)(srow + 32 * ps) * 1024 + kt * 64 + sch * 8);
  }
}
DI void gemm_write(char* buf, int srow, int sch, const u32x4 (&pr)[4], const u32x4 (&qr)[4]) {
#pragma unroll
  for (int ps = 0; ps < 4; ++ps) {
    *(u32x4*)(buf + swz128(srow + 32 * ps, sch)) = pr[ps];
    *(u32x4*)(buf + 16384 + swz128(srow + 32 * ps, sch)) = qr[ps];
  }
}
DI void gemm_compute(const char* cur, int wi, int wj, int r, int h, f32x16 (&acc)[2][2]) {
  bf16x8 a[2][2], bq[2][2];
#pragma unroll
  for (int mi = 0; mi < 2; ++mi) a[0][mi] = *(const bf16x8*)(cur + swz128(wi * 64 + mi * 32 + r, h));
#pragma unroll
  for (int nj = 0; nj < 2; ++nj) bq[0][nj] = *(const bf16x8*)(cur + 16384 + swz128(wj * 64 + nj * 32 + r, h));
#pragma unroll
  for (int kk = 0; kk < 4; ++kk) {
    if (kk < 3) {
#pragma unroll
      for (int mi = 0; mi < 2; ++mi) a[(kk + 1) & 1][mi] = *(const bf16x8*)(cur + swz128(wi * 64 + mi * 32 + r, (kk + 1) * 2 + h));
#pragma unroll
      for (int nj = 0; nj < 2; ++nj) bq[(kk + 1) & 1][nj] = *(const bf16x8*)(cur + 16384 + swz128(wj * 64 + nj * 32 + r, (kk + 1) * 2 + h));
    }
    __builtin_amdgcn_sched_barrier(0);
#pragma unroll
    for (int mi = 0; mi < 2; ++mi)
#pragma unroll
      for (int nj = 0; nj < 2; ++nj) acc[mi][nj] = MFMA32(a[kk & 1][mi], bq[kk & 1][nj], acc[mi][nj]);
    __builtin_amdgcn_sched_barrier(0);
  }
}
DI void gemm_dma(const ushort_t* __restrict__ P, const ushort_t* __restrict__ Q, int kt, char* buf, int srow, int csrc, int wid) {
#pragma unroll
  for (int ps = 0; ps < 4; ++ps) {
    const size_t go = (size_t)(srow + 32 * ps) * 1024 + kt * 64 + csrc * 8;
    __builtin_amdgcn_global_load_lds((const unsigned*)(P + go), (unsigned*)(buf + ps * 4096 + wid * 1024), 16, 0, 0);
    __builtin_amdgcn_global_load_lds((const unsigned*)(Q + go), (unsigned*)(buf + 16384 + ps * 4096 + wid * 1024), 16, 0, 0);
  }
}
DI void gemm_main(const ushort_t* __restrict__ P, const ushort_t* __restrict__ Q, char* smem, f32x16 (&acc)[2][2], const int tid) {
  const int lane = tid & 63, w = tid >> 6, wi = w >> 1, wj = w & 1;
  const int r = lane & 31, h = lane >> 5;
  const int srow = tid >> 3, csrc = (tid & 7) ^ ((srow >> 1) & 7);
  const int wid = __builtin_amdgcn_readfirstlane(w);
  gemm_dma(P, Q, 0, smem, srow, csrc, wid);
  asm volatile("s_waitcnt vmcnt(0)" ::: "memory");
  __syncthreads();
#pragma unroll 1
  for (int kt = 0; kt < 16; ++kt) {
    char* cur = smem + (kt & 1) * 32768;
    char* nxt = smem + ((kt + 1) & 1) * 32768;
    if (kt + 1 < 16) gemm_dma(P, Q, kt + 1, nxt, srow, csrc, wid);
    gemm_compute(cur, wi, wj, r, h, acc);
    asm volatile("s_waitcnt vmcnt(0)" ::: "memory");
    __syncthreads();
  }
}

DI void zero_acc(f32x16 (&acc)[2][2]) {
#pragma unroll
  for (int a = 0; a < 2; ++a)
#pragma unroll
    for (int b = 0; b < 2; ++b)
#pragma unroll
      for (int i = 0; i < 16; ++i) acc[a][b][i] = 0.f;
}

DI void phase_qkv(const Params& p, int layer, char* smem) {
  const int tid = opaque_tid(), lane = tid & 63, w = tid >> 6, wi = w >> 1, wj = w & 1;
  const int r = lane & 31, h = lane >> 5;
  const int NI = layer == 0 ? 18 : 24;
  const ushort_t* W = layer == 0 ? P_WABIN : P_WCIN;
  const int ntiles = NI * 264;
  constexpr int SST = 272;
  for (int id = blockIdx.x; id < ntiles; id += gridDim.x) {
    const int jt = id / NI, it = id - jt * NI;
    const int f0 = it * 128, t0 = jt * 128;
    const int hu0 = f0 >> 6;
    int kind, dcol0;
    const float* gain;
    if (layer == 0) {
      if (hu0 < 8) { kind = 0; dcol0 = hu0 * 64; gain = p.a_qn; }
      else if (hu0 < 10) { kind = 1; dcol0 = (hu0 - 8) * 64; gain = p.a_kn; }
      else if (hu0 < 12) { kind = 2; dcol0 = (hu0 - 10) * 64; gain = p.a_qn; }
      else if (hu0 < 20) { kind = 0; dcol0 = 512 + (hu0 - 12) * 64; gain = p.b_qn; }
      else if (hu0 < 28) { kind = 1; dcol0 = 128 + (hu0 - 20) * 64; gain = p.b_kn; }
      else { kind = 2; dcol0 = 128 + (hu0 - 28) * 64; gain = p.a_qn; }
    } else {
      if (hu0 < 16) { kind = 0; dcol0 = hu0 * 64; gain = p.c_qn; }
      else if (hu0 < 32) { kind = 1; dcol0 = (hu0 - 16) * 64; gain = p.c_kn; }
      else { kind = 2; dcol0 = (hu0 - 32) * 64; gain = p.c_qn; }
    }
    const int b = t0 / LKB;
    const int pp0 = t0 - b * LKB;
    f32x16 acc[2][2];
    zero_acc(acc);
    if (kind == 2) gemm_main(P_H + (size_t)t0 * 1024, W + (size_t)f0 * 1024, smem, acc, tid);
    else gemm_main(W + (size_t)f0 * 1024, P_H + (size_t)t0 * 1024, smem, acc, tid);
    char* stg = smem;
#pragma unroll
    for (int nj = 0; nj < 2; ++nj) {
      const int jrow = wj * 64 + nj * 32 + r;
      char* srow_p = stg + jrow * SST + (wi * 64 + 4 * h) * 2;
      if (kind == 2) {
#pragma unroll
        for (int mi = 0; mi < 2; ++mi)
#pragma unroll
          for (int g = 0; g < 4; ++g)
            *(uint2*)(srow_p + (mi * 32 + 8 * g) * 2) = make_uint2(pack2(acc[mi][nj][4 * g], acc[mi][nj][4 * g + 1]),
                                                                  pack2(acc[mi][nj][4 * g + 2], acc[mi][nj][4 * g + 3]));
      } else {
        const int pp = pp0 + jrow;
        float ss = 0.f;
#pragma unroll
        for (int mi = 0; mi < 2; ++mi)
#pragma unroll
          for (int reg = 0; reg < 16; ++reg) ss += acc[mi][nj][reg] * acc[mi][nj][reg];
        ss += __shfl_xor(ss, 32);
        const float rn = rsqrtf(ss * (1.f / 64.f) + 1e-6f);
        const float sc = (kind == 0) ? 0.125f * LOG2E : 1.f;
        const bool rope = (layer == 0) && (pp >= 256);
        const int s = pp - 256;
#pragma unroll
        for (int mi = 0; mi < 2; ++mi) {
          float v[16];
#pragma unroll
          for (int reg = 0; reg < 16; ++reg) v[reg] = acc[mi][nj][reg] * rn * gain[mi * 32 + crow(reg, h)];
          if (rope) {
            const int ps = (mi == 0) ? (s >> 6) : (s & 63);
#pragma unroll
            for (int q = 0; q < 8; ++q) {
              const float2 cs = P_ROPE[ps * 16 + crow(q, h)];
              const float x1 = v[q], x2 = v[q + 8];
              v[q] = x1 * cs.x - x2 * cs.y;
              v[q + 8] = x1 * cs.y + x2 * cs.x;
            }
          }
#pragma unroll
          for (int g = 0; g < 4; ++g)
            *(uint2*)(srow_p + (mi * 32 + 8 * g) * 2) =
                make_uint2(pack2(v[4 * g] * sc, v[4 * g + 1] * sc), pack2(v[4 * g + 2] * sc, v[4 * g + 3] * sc));
        }
      }
    }
    __syncthreads();
    ushort_t* obase;
    size_t ostride;
    if (kind == 2) { obase = P_VT + ((size_t)(b * 1024 + dcol0)) * LKB + pp0; ostride = LKB; }
    else { obase = (kind == 0 ? P_QB : P_KB) + (size_t)t0 * 1024 + dcol0; ostride = 1024; }
#pragma unroll
    for (int i = 0; i < 8; ++i) {
      const int idx = tid + 256 * i;
      const int row = idx >> 4, ch = idx & 15;
      const u32x4 val = *(const u32x4*)(stg + row * SST + ch * 16);
      *(u32x4*)(obase + (size_t)row * ostride + ch * 8) = val;
    }
    __syncthreads();
  }
}

DI void phase_outproj(const Params& p, int layer, char* smem) {
  const int tid = opaque_tid(), lane = tid & 63, w = tid >> 6, wi = w >> 1, wj = w & 1;
  const int r = lane & 31, h = lane >> 5;
  const ushort_t* W = layer == 0 ? P_WABOUT : P_WCOUT;
  const int ntok_tiles = layer == 0 ? 264 : 256;
  for (int id = blockIdx.x; id < ntok_tiles * 8; id += gridDim.x) {
    int it = id >> 3;
    const int jt = id & 7;
    if (layer == 1) it = (it >> 6) * 66 + 2 + (it & 63);
    const int i0 = it * 128, j0 = jt * 128;
    f32x16 acc[2][2];
    zero_acc(acc);
    gemm_main(P_H + (size_t)i0 * 1024, W + (size_t)j0 * 1024, smem, acc, tid);
    const int b = i0 / LKB, pp0 = i0 - b * LKB;
    const bool isctx = pp0 < 256;
    const int mr = isctx ? 4 : b;
    const float* gate = P_MOD + (layer * 5 + mr) * 6144 + 2 * 1024;
    const float* xin_base;
    if (layer == 0) xin_base = isctx ? p.ctx + ((size_t)b * 256 + pp0) * 1024 : p.x + ((size_t)b * 8192 + (pp0 - 256)) * 1024;
    else xin_base = P_R + (size_t)i0 * 1024;
    float* r_base = P_R + (size_t)i0 * 1024 + j0;
    xin_base += j0;
    unsigned lane_off = (unsigned)((wi * 64 + 4 * h) * 1024 + wj * 64 + r);
    asm volatile("" : "+v"(lane_off));
#pragma unroll
    for (int nj = 0; nj < 2; ++nj) {
      const float gt = gate[j0 + wj * 64 + nj * 32 + r];
#pragma unroll
      for (int mi = 0; mi < 2; ++mi) {
        float xin[16];
#pragma unroll
        for (int reg = 0; reg < 16; ++reg)
          xin[reg] = xin_base[lane_off + (unsigned)((mi * 32 + (reg & 3) + 8 * (reg >> 2)) * 1024 + nj * 32)];
#pragma unroll
        for (int reg = 0; reg < 16; ++reg)
          r_base[lane_off + (unsigned)((mi * 32 + (reg & 3) + 8 * (reg >> 2)) * 1024 + nj * 32)] = xin[reg] + gt * acc[mi][nj][reg];
      }
    }
  }
}

template <int NDF, int MODE, int DEAD = -1>
DI bool attn_tile(const bool safe, const bool zref, const char* Ks, const char* Vs, const bf16x8 (&qf)[4], f32x16 (&O)[NDF], float& mref, float& l,
                  const bool first, int lane, int cs, const float* bias_row) {
  const int r = lane & 31, h = lane >> 5;
  const int pr = (r & ~12) | ((r & 4) << 1) | ((r & 8) >> 1);
  f32x16 S[2];
  {
    const bf16x8 a0 = *(const bf16x8*)(Ks + swz128(pr, h));
    const bf16x8 a1 = *(const bf16x8*)(Ks + swz128(32 + pr, h));
    if (zref) {
      f32x16 z;
#pragma unroll
      for (int i = 0; i < 16; ++i) z[i] = 0.f;
      S[0] = MFMA32(a0, qf[0], z);
      S[1] = MFMA32(a1, qf[0], z);
    } else {
      f32x16 z;
      const float sinit = -mref;
#pragma unroll
      for (int i = 0; i < 16; ++i) z[i] = sinit;
      S[0] = MFMA32(a0, qf[0], z);
      S[1] = MFMA32(a1, qf[0], z);
    }
  }
#pragma unroll
  for (int kk = 1; kk < 4; ++kk)
#pragma unroll
    for (int kf = 0; kf < 2; ++kf) {
      const bf16x8 a = *(const bf16x8*)(Ks + swz128(kf * 32 + pr, kk * 2 + h));
      S[kf] = MFMA32(a, qf[kk], S[kf]);
    }
  if (MODE == 1) {
    const float* brow = bias_row + 8 * h;
    const int csh = cs - 8 * h;
#pragma unroll
    for (int kf = 0; kf < 2; ++kf) {
#pragma unroll
      for (int reg = 0; reg < 16; ++reg) {
        if (kf * 2 + (reg >> 3) == DEAD) continue;
        const int kc0 = kf * 32 + 16 * (reg >> 3) + (reg & 7);
        const bool valid = (unsigned)(kc0 - csh) < 16u;
        S[kf][reg] = valid ? S[kf][reg] + brow[kc0] : -INFINITY;
      }
      __builtin_amdgcn_sched_barrier(0);
    }
  }
  bool slow = false;
  if (!safe) {
  float mx = -INFINITY;
#pragma unroll
  for (int kf = 0; kf < 2; ++kf)
#pragma unroll
    for (int reg = 0; reg < 16; ++reg) {
      if (kf * 2 + (reg >> 3) == DEAD) continue;
      mx = fmaxf(mx, S[kf][reg]);
    }
  const bool ok = first ? (fabsf(mx) <= 20.f) : (mx <= 20.f);
  slow = !__all(ok);
  if (slow) {
    mx = fmaxf(mx, __shfl_xor(mx, 32));
    const float mnew = first ? fmaxf(mx, -64.f) : fmaxf(mx, 0.f);
    const float alpha = __builtin_amdgcn_exp2f(-mnew);
    mref += mnew;
    l *= alpha;
#pragma unroll
    for (int kf = 0; kf < 2; ++kf)
#pragma unroll
      for (int reg = 0; reg < 16; ++reg) S[kf][reg] -= mnew;
#pragma unroll
    for (int df = 0; df < NDF; ++df)
#pragma unroll
      for (int i = 0; i < 16; ++i) O[df][i] *= alpha;
  }
  }
  float rs = 0.f;
#pragma unroll
  for (int kf = 0; kf < 2; ++kf)
#pragma unroll
    for (int reg = 0; reg < 16; ++reg) {
      if (kf * 2 + (reg >> 3) == DEAD) continue;
      const float pv = __builtin_amdgcn_exp2f(S[kf][reg]);
      S[kf][reg] = pv;
      rs += pv;
    }
  l += rs;
#pragma unroll
  for (int kf = 0; kf < 2; ++kf)
#pragma unroll
    for (int s2 = 0; s2 < 2; ++s2) {
      if (kf * 2 + s2 == DEAD) continue;
      const unsigned w0 = pack2(S[kf][8 * s2 + 0], S[kf][8 * s2 + 1]), w1 = pack2(S[kf][8 * s2 + 2], S[kf][8 * s2 + 3]);
      const unsigned w2 = pack2(S[kf][8 * s2 + 4], S[kf][8 * s2 + 5]), w3 = pack2(S[kf][8 * s2 + 6], S[kf][8 * s2 + 7]);
      const uint4 pk = make_uint4(w0, w1, w2, w3);
      const bf16x8 pb = __builtin_bit_cast(bf16x8, pk);
      const int ks = kf * 2 + s2;
#pragma unroll
      for (int df = 0; df < NDF; ++df) {
        const bf16x8 a = *(const bf16x8*)(Vs + swz128(df * 32 + r, ks * 2 + h));
        O[df] = MFMA32(a, pb, O[df]);
      }
    }
  return slow;
}
template <int NDF, int MODE, int DEAD = -1>
DI void attn_tile_z(const bool safe, bool& zref, const char* Ks, const char* Vs, const bf16x8 (&qf)[4], f32x16 (&O)[NDF], float& mref, float& l,
                    const bool first, int lane, int cs, const float* bias_row) {
  const bool slow = attn_tile<NDF, MODE, DEAD>(safe, zref, Ks, Vs, qf, O, mref, l, first, lane, cs, bias_row);
  if (slow) zref = __all(mref == 0.f) != 0;
}

template <int KM, int NDF>
DI void attn_stage_load(const Params& p, size_t krow_u, int kcol, size_t vt_row0, int vt_col, u32x4 (&kr)[2 * KM], u32x4 (&vr)[NDF], const int tid) {
#pragma unroll
  for (int i = 0; i < 2 * KM; ++i) {
    const int id = tid + 256 * i;
    const int row = id / (8 * KM), c = id % (8 * KM);
    kr[i] = *(const u32x4*)(P_KB + (krow_u + row) * 1024 + kcol + c * 8);
  }
#pragma unroll
  for (int i = 0; i < NDF; ++i) {
    const int id = tid + 256 * i;
    const int row = id >> 3, c = id & 7;
    vr[i] = *(const u32x4*)(P_VT + (vt_row0 + row) * LKB + vt_col + c * 8);
  }
}
template <int KM, int NDF>
DI void attn_stage_write(char* buf, const u32x4 (&kr)[2 * KM], const u32x4 (&vr)[NDF], const int tid) {
#pragma unroll
  for (int i = 0; i < 2 * KM; ++i) {
    const int id = tid + 256 * i;
    const int row = id / (8 * KM), c = id % (8 * KM);
    *(u32x4*)(buf + (c >> 3) * 8192 + swz128(row, c & 7)) = kr[i];
  }
#pragma unroll
  for (int i = 0; i < NDF; ++i) {
    const int id = tid + 256 * i;
    const int row = id >> 3, c = id & 7;
    *(u32x4*)(buf + KM * 8192 + swz128(row, c)) = vr[i];
  }
}

template <int KM, int NDF>
DI void attn_stage_dma(const Params& p, size_t krow_u, int kcol, size_t vt_row0, int vt_col, char* buf, const int tid) {
  const int lane = tid & 63, lr = lane >> 3, pc = lane & 7;
  const int wid = __builtin_amdgcn_readfirstlane(tid >> 6);
#pragma unroll
  for (int i = 0; i < 2 * KM; ++i) {
    const int pcs = i * 4 + wid, mat = pcs >> 3, prow0 = (pcs & 7) * 8;
    const int row = prow0 + lr, lc = pc ^ ((row >> 1) & 7);
    __builtin_amdgcn_global_load_lds((const unsigned*)(P_KB + (krow_u + row) * 1024 + kcol + mat * 64 + lc * 8),
                                     (unsigned*)(buf + mat * 8192 + prow0 * 128), 16, 0, 0);
  }
#pragma unroll
  for (int i = 0; i < NDF; ++i) {
    const int prow0 = (i * 4 + wid) * 8;
    const int row = prow0 + lr, lc = pc ^ ((row >> 1) & 7);
    __builtin_amdgcn_global_load_lds((const unsigned*)(P_VT + (vt_row0 + row) * LKB + vt_col + lc * 8),
                                     (unsigned*)(buf + KM * 8192 + prow0 * 128), 16, 0, 0);
  }
}

DI void load_qfrags(const ushort_t* qptr, int lane, bf16x8 (&qf)[4]) {
  const int r = lane & 31, h = lane >> 5;
#pragma unroll
  for (int kk = 0; kk < 4; ++kk) qf[kk] = *(const bf16x8*)(qptr + (size_t)r * 1024 + kk * 16 + 8 * h);
}

template <int DIFF>
DI void attn_item_l0(const Params& p, char* smem, int b, int head, int q0, int nt) {
  constexpr int KM = DIFF ? 2 : 1, NDF = DIFF ? 4 : 2;
  constexpr int BUFB = KM * 8192 + NDF * 4096;
  const int tid = opaque_tid(), lane = tid & 63, w = tid >> 6;
  const int r = lane & 31, h = lane >> 5;
  int qoff, qcol, km, kcol, vfeat;
  if (DIFF) { qoff = (w >> 1) * 32; km = w & 1; qcol = 512 + (head * 2 + km) * 64; kcol = 128 + head * 128; vfeat = 128 + head * 128; }
  else { qoff = w * 32; km = 0; qcol = head * 64; kcol = (head >> 2) * 64; vfeat = (head >> 2) * 64; }
  const size_t ub = (size_t)b * LKB;
  bf16x8 qf[4];
  load_qfrags(P_QB + (ub + q0 + qoff) * 1024 + qcol, lane, qf);
  f32x16 O[NDF];
#pragma unroll
  for (int df = 0; df < NDF; ++df)
#pragma unroll
    for (int i = 0; i < 16; ++i) O[df][i] = 0.f;
  float m = 0.f, l = 0.f;
  bool zref = true;
  const bool safe = P_SCAL[DIFF ? 2 : 1] <= 20.f;
  const size_t vt_row0 = (size_t)b * 1024 + vfeat;
  attn_stage_dma<KM, NDF>(p, ub, kcol, vt_row0, 0, smem, tid);
  asm volatile("s_waitcnt vmcnt(0)" ::: "memory");
  __syncthreads();
#pragma unroll 1
  for (int t = 0; t < nt; ++t) {
    char* cur = smem + (t & 1) * BUFB;
    char* nxt = smem + ((t + 1) & 1) * BUFB;
    if (t + 1 < nt) attn_stage_dma<KM, NDF>(p, ub + (t + 1) * 64, kcol, vt_row0, (t + 1) * 64, nxt, tid);
    attn_tile_z<NDF, 0>(safe, zref, cur + km * 8192, cur + KM * 8192, qf, O, m, l, t == 0, lane, 0, nullptr);
    asm volatile("s_waitcnt vmcnt(0)" ::: "memory");
    __syncthreads();
  }
  const float lt = l + __shfl_xor(l, 32);
  const float inv = 1.f / lt;
  const size_t uq = ub + q0 + qoff + r;
  if (!DIFF) {
    ushort_t* dst = P_H + uq * 1024 + head * 64;
#pragma unroll
    for (int df = 0; df < NDF; ++df)
#pragma unroll
      for (int g = 0; g < 4; ++g)
        *(uint2*)(dst + df * 32 + 8 * g + 4 * h) = make_uint2(pack2(O[df][4 * g] * inv, O[df][4 * g + 1] * inv),
                                                              pack2(O[df][4 * g + 2] * inv, O[df][4 * g + 3] * inv));
  } else {
    float* mg = (float*)smem;
    if (km == 1) {
#pragma unroll
      for (int df = 0; df < NDF; ++df)
#pragma unroll
        for (int i = 0; i < 16; ++i) mg[((w >> 1) * 64 + df * 16 + i) * 64 + lane] = O[df][i] * inv;
    }
    __syncthreads();
    if (km == 0) {
      const float lam = P_SCAL[0];
      float ss = 0.f;
#pragma unroll
      for (int df = 0; df < NDF; ++df)
#pragma unroll
        for (int i = 0; i < 16; ++i) {
          const float v = O[df][i] * inv - lam * mg[((w >> 1) * 64 + df * 16 + i) * 64 + lane];
          O[df][i] = v;
          ss += v * v;
        }
      ss += __shfl_xor(ss, 32);
      const float rn = rsqrtf(ss * (1.f / 128.f) + 1e-6f) * 0.8f;
      ushort_t* dst = P_H + uq * 1024 + 512 + head * 128;
#pragma unroll
      for (int df = 0; df < NDF; ++df)
#pragma unroll
        for (int g = 0; g < 4; ++g) {
          const int d = df * 32 + 8 * g + 4 * h;
          const float4 sg = *(const float4*)(p.b_subln + d);
          *(uint2*)(dst + d) = make_uint2(pack2(O[df][4 * g] * rn * sg.x, O[df][4 * g + 1] * rn * sg.y),
                                          pack2(O[df][4 * g + 2] * rn * sg.z, O[df][4 * g + 3] * rn * sg.w));
        }
    }
    __syncthreads();
  }
}

DI bool attn_tile2(const bool safe, const bool zref, const char* Ks, const char* Vs, const bf16x8 (&qf)[2][4], f32x16 (&O)[2][2], float (&mref)[2],
                   float (&l)[2], const bool first, int lane) {
  const int r = lane & 31, h = lane >> 5;
  const int pr = (r & ~12) | ((r & 4) << 1) | ((r & 8) >> 1);
  f32x16 S[2][2];
  {
    const bf16x8 a0 = *(const bf16x8*)(Ks + swz128(pr, h));
    const bf16x8 a1 = *(const bf16x8*)(Ks + swz128(32 + pr, h));
    if (zref) {
      f32x16 z;
#pragma unroll
      for (int i = 0; i < 16; ++i) z[i] = 0.f;
#pragma unroll
      for (int q = 0; q < 2; ++q) { S[q][0] = MFMA32(a0, qf[q][0], z); S[q][1] = MFMA32(a1, qf[q][0], z); }
    } else {
#pragma unroll
      for (int q = 0; q < 2; ++q) {
        f32x16 z;
        const float sinit = -mref[q];
#pragma unroll
        for (int i = 0; i < 16; ++i) z[i] = sinit;
        S[q][0] = MFMA32(a0, qf[q][0], z);
        S[q][1] = MFMA32(a1, qf[q][0], z);
      }
    }
  }
#pragma unroll
  for (int kk = 1; kk < 4; ++kk)
#pragma unroll
    for (int kf = 0; kf < 2; ++kf) {
      const bf16x8 a = *(const bf16x8*)(Ks + swz128(kf * 32 + pr, kk * 2 + h));
#pragma unroll
      for (int q = 0; q < 2; ++q) S[q][kf] = MFMA32(a, qf[q][kk], S[q][kf]);
    }
  bool slow = false;
  if (!safe) {
  float mx[2];
#pragma unroll
  for (int q = 0; q < 2; ++q) {
    mx[q] = S[q][0][0];
#pragma unroll
    for (int kf = 0; kf < 2; ++kf)
#pragma unroll
      for (int reg = 0; reg < 16; ++reg) mx[q] = fmaxf(mx[q], S[q][kf][reg]);
  }
  const bool ok = first ? (fabsf(mx[0]) <= 20.f && fabsf(mx[1]) <= 20.f) : (fmaxf(mx[0], mx[1]) <= 20.f);
  slow = !__all(ok);
  if (slow) {
#pragma unroll
    for (int q = 0; q < 2; ++q) {
      const float mxq = fmaxf(mx[q], __shfl_xor(mx[q], 32));
      const float mnew = first ? fmaxf(mxq, -64.f) : fmaxf(mxq, 0.f);
      const float alpha = __builtin_amdgcn_exp2f(-mnew);
      mref[q] += mnew;
      l[q] *= alpha;
#pragma unroll
      for (int kf = 0; kf < 2; ++kf)
#pragma unroll
        for (int reg = 0; reg < 16; ++reg) S[q][kf][reg] -= mnew;
#pragma unroll
      for (int df = 0; df < 2; ++df)
#pragma unroll
        for (int i = 0; i < 16; ++i) O[q][df][i] *= alpha;
    }
  }
  }
#pragma unroll
  for (int q = 0; q < 2; ++q) {
    float rs = 0.f;
#pragma unroll
    for (int kf = 0; kf < 2; ++kf)
#pragma unroll
      for (int reg = 0; reg < 16; ++reg) {
        const float pv = __builtin_amdgcn_exp2f(S[q][kf][reg]);
        S[q][kf][reg] = pv;
        rs += pv;
      }
    l[q] += rs;
  }
#pragma unroll
  for (int kf = 0; kf < 2; ++kf)
#pragma unroll
    for (int s2 = 0; s2 < 2; ++s2) {
      bf16x8 pb[2];
#pragma unroll
      for (int q = 0; q < 2; ++q) {
        const uint4 pk = make_uint4(pack2(S[q][kf][8 * s2 + 0], S[q][kf][8 * s2 + 1]), pack2(S[q][kf][8 * s2 + 2], S[q][kf][8 * s2 + 3]),
                                    pack2(S[q][kf][8 * s2 + 4], S[q][kf][8 * s2 + 5]), pack2(S[q][kf][8 * s2 + 6], S[q][kf][8 * s2 + 7]));
        pb[q] = __builtin_bit_cast(bf16x8, pk);
      }
      const int ks = kf * 2 + s2;
#pragma unroll
      for (int df = 0; df < 2; ++df) {
        const bf16x8 a = *(const bf16x8*)(Vs + swz128(df * 32 + r, ks * 2 + h));
#pragma unroll
        for (int q = 0; q < 2; ++q) O[q][df] = MFMA32(a, pb[q], O[q][df]);
      }
    }
  return slow;
}

DI void attn_item_gqa2(const Params& p, char* smem, int b, int head, int q0, int nt) {
  constexpr int BUFB = 16384;
  const int tid = opaque_tid(), lane = tid & 63, w = tid >> 6;
  const int r = lane & 31, h = lane >> 5;
  const int qoff = w * 64, qcol = head * 64, kcol = (head >> 2) * 64, vfeat = (head >> 2) * 64;
  const size_t ub = (size_t)b * LKB;
  bf16x8 qf[2][4];
  load_qfrags(P_QB + (ub + q0 + qoff) * 1024 + qcol, lane, qf[0]);
  load_qfrags(P_QB + (ub + q0 + qoff + 32) * 1024 + qcol, lane, qf[1]);
  f32x16 O[2][2];
#pragma unroll
  for (int q = 0; q < 2; ++q)
#pragma unroll
    for (int df = 0; df < 2; ++df)
#pragma unroll
      for (int i = 0; i < 16; ++i) O[q][df][i] = 0.f;
  float m[2] = {0.f, 0.f}, l[2] = {0.f, 0.f};
  bool zref = true;
  const bool safe = P_SCAL[1] <= 20.f;
  const size_t vt_row0 = (size_t)b * 1024 + vfeat;
  attn_stage_dma<1, 2>(p, ub, kcol, vt_row0, 0, smem, tid);
  asm volatile("s_waitcnt vmcnt(0)" ::: "memory");
  __syncthreads();
#pragma unroll 1
  for (int t = 0; t < nt; ++t) {
    char* cur = smem + (t & 1) * BUFB;
    char* nxt = smem + ((t + 1) & 1) * BUFB;
    if (t + 1 < nt) attn_stage_dma<1, 2>(p, ub + (t + 1) * 64, kcol, vt_row0, (t + 1) * 64, nxt, tid);
    const bool slow = attn_tile2(safe, zref, cur, cur + 8192, qf, O, m, l, t == 0, lane);
    if (slow) zref = __all(m[0] == 0.f && m[1] == 0.f) != 0;
    asm volatile("s_waitcnt vmcnt(0)" ::: "memory");
    __syncthreads();
  }
#pragma unroll
  for (int q = 0; q < 2; ++q) {
    const float lt = l[q] + __shfl_xor(l[q], 32);
    const float inv = 1.f / lt;
    ushort_t* dst = P_H + (ub + q0 + qoff + q * 32 + r) * 1024 + head * 64;
#pragma unroll
    for (int df = 0; df < 2; ++df)
#pragma unroll
      for (int g = 0; g < 4; ++g)
        *(uint2*)(dst + df * 32 + 8 * g + 4 * h) = make_uint2(pack2(O[q][df][4 * g] * inv, O[q][df][4 * g + 1] * inv),
                                                              pack2(O[q][df][4 * g + 2] * inv, O[q][df][4 * g + 3] * inv));
  }
}

DI void phase_attn_l0(const Params& p, char* smem) {
  const int xcd = blockIdx.x & 7, lb = blockIdx.x >> 3, nbx = gridDim.x >> 3;
  for (int it = lb; it < 132; it += nbx) {
    if (it < 128) {
      const int b = xcd >> 1, hq = (xcd & 1) * 4 + (it >> 5), qb = it & 31;
      attn_item_gqa2(p, smem, b, hq, 256 + qb * 256, 132);
    } else {
      const int b = xcd >> 1, hq = (xcd & 1) * 4 + (it - 128);
      attn_item_gqa2(p, smem, b, hq, 0, 4);
    }
  }
  for (int it = lb; it < 264; it += nbx) {
    if (it < 256) {
      const int combo = xcd * 2 + (it >> 7), qb = it & 127;
      attn_item_l0<1>(p, smem, combo >> 2, combo & 3, 256 + qb * 64, 132);
    } else {
      const int j = it - 256, combo = xcd * 2 + (j >> 2), qb = j & 3;
      attn_item_l0<1>(p, smem, combo >> 2, combo & 3, qb * 64, 4);
    }
  }
}

DI int rs_of(int row) { return min(max(row - 4, 0), 120); }
DI void phase_attn_l1(const Params& p, char* smem) {
  constexpr int BUFB = 16384;
  const int tid = opaque_tid(), lane = tid & 63, w = tid >> 6;
  const int r = lane & 31, h = lane >> 5;
  float* rpbL = (float*)(smem + 32768);
  int cur_h = -1;
  for (int it = blockIdx.x; it < 4096; it += gridDim.x) {
    const int b = it >> 10, rp = (it >> 4) & 63, hh = it & 15;
    const int r0 = rp * 2;
    const int rsA = rs_of(r0), rsB = rs_of(r0 + 1) + 7;
    const int nwin = rsB - rsA + 1, nt = nwin + 4;
    const int row = r0 + (w >> 1), qfi = w & 1;
    const int rsw = rs_of(row);
    const int j = qfi * 32 + r;
    const int cs = min(max(j - 8, 0), 48);
    const size_t ub = (size_t)b * LKB;
    if (hh != cur_h) {
      __syncthreads();
      for (int i = tid; i < 465; i += 256) rpbL[i] = p.c_rpb[hh * 465 + i] * LOG2E;
      cur_h = hh;
    }
    bf16x8 qf[4];
    load_qfrags(P_QB + (ub + 256 + row * 64 + qfi * 32) * 1024 + hh * 64, lane, qf);
    f32x16 O[2];
#pragma unroll
    for (int df = 0; df < 2; ++df)
#pragma unroll
      for (int i = 0; i < 16; ++i) O[df][i] = 0.f;
    float m = 0.f, l = 0.f;
    bool zref = true;
    const bool safe = P_SCAL[3] <= 20.f;
    const size_t vt_row0 = (size_t)b * 1024 + hh * 64;
    {
      const int kp = 256 + rsA * 64;
      attn_stage_dma<1, 2>(p, ub + kp, hh * 64, vt_row0, kp, smem, tid);
    }
    asm volatile("s_waitcnt vmcnt(0)" ::: "memory");
    __syncthreads();
#pragma unroll 1
    for (int t = 0; t < nt; ++t) {
      char* cur = smem + (t & 1) * BUFB;
      char* nxt = smem + ((t + 1) & 1) * BUFB;
      if (t + 1 < nt) {
        const int kp = (t + 1 < nwin) ? 256 + (rsA + t + 1) * 64 : (t + 1 - nwin) * 64;
        attn_stage_dma<1, 2>(p, ub + kp, hh * 64, vt_row0, kp, nxt, tid);
      }
      if (t < nwin) {
        const int krw = rsA + t;
        const bool inband = (krw >= rsw) && (krw <= rsw + 7);
        if (__builtin_amdgcn_readfirstlane(qfi) == 0)
          attn_tile_z<2, 1, 3>(safe, zref, cur, cur + 8192, qf, O, m, l, krw == rsw, lane, inband ? cs : 1000, rpbL + (krw - row + 7) * 31 + 15 - j);
        else
          attn_tile_z<2, 1, 0>(safe, zref, cur, cur + 8192, qf, O, m, l, krw == rsw, lane, inband ? cs : 1000, rpbL + (krw - row + 7) * 31 + 15 - j);
      } else {
        attn_tile_z<2, 0>(safe, zref, cur, cur + 8192, qf, O, m, l, false, lane, 0, nullptr);
      }
      asm volatile("s_waitcnt vmcnt(0)" ::: "memory");
      __syncthreads();
    }
    const float lt = l + __shfl_xor(l, 32);
    const float inv = 1.f / lt;
    ushort_t* dst = P_H + (ub + 256 + row * 64 + j) * 1024 + hh * 64;
#pragma unroll
    for (int df = 0; df < 2; ++df)
#pragma unroll
      for (int g = 0; g < 4; ++g)
        *(uint2*)(dst + df * 32 + 8 * g + 4 * h) = make_uint2(pack2(O[df][4 * g] * inv, O[df][4 * g + 1] * inv),
                                                              pack2(O[df][4 * g + 2] * inv, O[df][4 * g + 3] * inv));
  }
}

DI void phase_peerq(const Params& p, int layer, char* smem) {
  const int tid = opaque_tid(), lane = tid & 63, w = tid >> 6, wi_ = w >> 1, wj_ = w & 1;
  const int r_ = lane & 31, h_ = lane >> 5;
  const int ntok_tiles = layer == 0 ? 264 : 256;
  for (int id = blockIdx.x; id < ntok_tiles * 16; id += gridDim.x) {
    int jt = id >> 4;
    const int it = id & 15;
    if (layer == 1) jt = (jt >> 6) * 66 + 2 + (jt & 63);
    const int j0 = jt * 128;
    f32x16 acc[2][2];
    zero_acc(acc);
    gemm_main(P_WPQ + ((size_t)layer * 2048 + it * 128) * 1024, P_H + (size_t)j0 * 1024, smem, acc, tid);
    char* pqs = smem;
    char* kss = smem + 32768;
    int r = r_, h = h_, wi = wi_, wj = wj_;
    asm volatile("" : "+v"(r), "+v"(h), "+v"(wi), "+v"(wj));
#pragma unroll
    for (int nj = 0; nj < 2; ++nj) {
      const int tok = wj * 64 + nj * 32 + r;
#pragma unroll
      for (int mi = 0; mi < 2; ++mi)
#pragma unroll
        for (int g = 0; g < 4; ++g) {
          const int d = wi * 64 + mi * 32 + 8 * g + 4 * h;
          *(uint2*)(pqs + swz256(tok, d >> 3) + (d & 7) * 2) =
              make_uint2(pack2(acc[mi][nj][4 * g], acc[mi][nj][4 * g + 1]), pack2(acc[mi][nj][4 * g + 2], acc[mi][nj][4 * g + 3]));
        }
    }
    const ushort_t* kg = P_KEYS + ((size_t)layer * 16 + it) * 128 * 128;
#pragma unroll
    for (int i = 0; i < 8; ++i) {
      const int idc = tid + 256 * i;
      const int row = idc >> 4, c = idc & 15;
      *(uint4*)(kss + swz256(row, c)) = *(const uint4*)(kg + row * 128 + c * 8);
    }
    __syncthreads();
    zero_acc(acc);
#pragma unroll
    for (int kk = 0; kk < 8; ++kk) {
      bf16x8 a[2], bq[2];
#pragma unroll
      for (int mi = 0; mi < 2; ++mi) a[mi] = *(const bf16x8*)(kss + swz256(wi * 64 + mi * 32 + r, kk * 2 + h));
#pragma unroll
      for (int nj = 0; nj < 2; ++nj) bq[nj] = *(const bf16x8*)(pqs + swz256(wj * 64 + nj * 32 + r, kk * 2 + h));
#pragma unroll
      for (int mi = 0; mi < 2; ++mi)
#pragma unroll
        for (int nj = 0; nj < 2; ++nj) acc[mi][nj] = MFMA32(a[mi], bq[nj], acc[mi][nj]);
    }
    __syncthreads();
    float* sc = (float*)smem;
#pragma unroll
    for (int mi = 0; mi < 2; ++mi)
#pragma unroll
      for (int nj = 0; nj < 2; ++nj)
#pragma unroll
        for (int reg = 0; reg < 16; ++reg)
          sc[(wi * 64 + mi * 32 + crow(reg, h)) * 128 + wj * 64 + nj * 32 + r] = acc[mi][nj][reg];
    __syncthreads();
    const int tok = tid & 127, half = tid >> 7;
    float v[16];
#pragma unroll
    for (int k = 0; k < 16; ++k) v[k] = -INFINITY;
    for (int n = half * 64; n < half * 64 + 64; ++n) {
      float xk = __uint_as_float((__float_as_uint(sc[n * 128 + tok]) & ~127u) | (unsigned)n);
#pragma unroll
      for (int k = 0; k < 16; ++k) {
        const float hi = fmaxf(v[k], xk);
        xk = fminf(v[k], xk);
        v[k] = hi;
      }
    }
    __syncthreads();
    if (half == 1) {
#pragma unroll
      for (int k = 0; k < 16; ++k) sc[k * 128 + tok] = v[k];
    }
    __syncthreads();
    if (half == 0) {
#pragma unroll
      for (int q = 0; q < 16; ++q) {
        float xk = sc[q * 128 + tok];
#pragma unroll
        for (int k = 0; k < 16; ++k) {
          const float hi = fmaxf(v[k], xk);
          xk = fminf(v[k], xk);
          v[k] = hi;
        }
      }
      unsigned* dst = P_TOPK + ((size_t)(j0 + tok) * 16 + it) * 16;
#pragma unroll
      for (int q = 0; q < 4; ++q)
        *(uint4*)(dst + 4 * q) = make_uint4(__float_as_uint(v[4 * q]), __float_as_uint(v[4 * q + 1]), __float_as_uint(v[4 * q + 2]),
                                            __float_as_uint(v[4 * q + 3]));
    }
    __syncthreads();
  }
}

DI float gelu_fast(float x) {
  const float z = 0.7978845608028654f * (x + 0.044715f * x * x * x);
  return x * __builtin_amdgcn_rcpf(1.f + exp2f(-2.f * LOG2E * z));
}
DI float gelu_tanh(float x) { return 0.5f * x * (1.f + tanhf(0.7978845608028654f * (x + 0.044715f * x * x * x))); }

DI void peer_batch_load(const Params& p, const int* se, const float* sg, int eb, int lane, u32x4 (&ur)[8], u32x2 (&vr)[8],
                        float& uis_my, float& vis_my, float& g_my) {
  const int myq = eb * 8 + (lane >> 3);
  const int e_my = se[myq];
  g_my = sg[myq];
  uis_my = P_UIS[e_my];
  vis_my = P_VIS[e_my];
#pragma unroll
  for (int q = 0; q < 8; ++q) {
    const int ei = __builtin_amdgcn_readfirstlane(se[eb * 8 + q]);
    ur[q] = *(const u32x4*)(P_U8 + (size_t)ei * 1024 + lane * 16);
    vr[q] = *(const u32x2*)(P_V8 + (size_t)ei * 512 + lane * 8);
  }
}
DI void peer_batch_compute(const u32x4 (&ur)[8], const u32x2 (&vr)[8], float uscale, float vis_my, float g_my, const int (&xq)[4],
                           f32x2 (&yv)[8], int lane) {
  const bool b5 = (lane & 32) != 0, b4 = (lane & 16) != 0, b3 = (lane & 8) != 0;
  float d[8];
#pragma unroll
  for (int q = 0; q < 8; ++q) {
    int a = 0;
#pragma unroll
    for (int k = 0; k < 4; ++k) a = __builtin_amdgcn_sdot4((int)ur[q][k], xq[k], a, false);
    d[q] = (float)a;
  }
  float t4[4], t2[2], t1;
#pragma unroll
  for (int i = 0; i < 4; ++i) {
    const float snd = b5 ? d[i] : d[i + 4], kp = b5 ? d[i + 4] : d[i];
    t4[i] = kp + __shfl_xor(snd, 32);
  }
#pragma unroll
  for (int i = 0; i < 2; ++i) {
    const float snd = b4 ? t4[i] : t4[i + 2], kp = b4 ? t4[i + 2] : t4[i];
    t2[i] = kp + __shfl_xor(snd, 16);
  }
  {
    const float snd = b3 ? t2[0] : t2[1], kp = b3 ? t2[1] : t2[0];
    t1 = kp + dpp_f<0x140>(snd);
  }
  t1 += dpp_f<0x141>(t1);
  t1 += dpp_f<0x4E>(t1);
  t1 += dpp_f<0xB1>(t1);
  const float wmy = g_my * gelu_fast(t1 * uscale) * vis_my;
#pragma unroll
  for (int q = 0; q < 8; ++q) {
    const float wq = __builtin_bit_cast(float, __builtin_amdgcn_readlane(__builtin_bit_cast(int, wmy), 8 * q));
    const f32x2 w2 = {wq, wq};
#pragma unroll
    for (int k = 0; k < 2; ++k) {
      yv[4 * k + 0] += w2 * __builtin_amdgcn_cvt_scalef32_pk_f32_fp4(vr[q][k], 1.0f, 0);
      yv[4 * k + 1] += w2 * __builtin_amdgcn_cvt_scalef32_pk_f32_fp4(vr[q][k], 1.0f, 1);
      yv[4 * k + 2] += w2 * __builtin_amdgcn_cvt_scalef32_pk_f32_fp4(vr[q][k], 1.0f, 2);
      yv[4 * k + 3] += w2 * __builtin_amdgcn_cvt_scalef32_pk_f32_fp4(vr[q][k], 1.0f, 3);
    }
  }
}

DI void phase_peer_final(const Params& p, int layer, char* smem) {
  const int tid = opaque_tid(), lane = tid & 63, w = tid >> 6;
  const int wave = (blockIdx.x * 256 + tid) >> 6, nw = gridDim.x * 4;
  int* se = (int*)(smem + w * 2048);
  float* sg = (float*)(smem + w * 2048 + 512);
  float* sr = (float*)(smem + w * 2048 + 1024);
  int ci, cj;
  if (lane < 16) { ci = 0; cj = lane; }
  else if (lane < 24) { ci = 1; cj = lane - 16; }
  else if (lane < 29) { ci = 2; cj = lane - 24; }
  else if (lane < 33) { ci = 3; cj = lane - 29; }
  else if (lane < 36) { ci = 4; cj = lane - 33; }
  else if (lane < 42) { ci = 5 + ((lane - 36) >> 1); cj = (lane - 36) & 1; }
  else if (lane < 50) { ci = 8 + (lane - 42); cj = 0; }
  else { ci = 0; cj = 0; }
  const int ntok = (layer == 0) ? NTOK : 4 * 8192;
  u32x4 cx0, cx1;
  unsigned ck1[8], ck2[8];
  {
    const int idx0 = min(wave, ntok - 1);
    const int u0 = (layer == 0) ? idx0 : (idx0 >> 13) * LKB + 256 + (idx0 & 8191);
    cx0 = *(const u32x4*)(P_H + (size_t)u0 * 1024 + lane * 16);
    cx1 = *(const u32x4*)(P_H + (size_t)u0 * 1024 + lane * 16 + 8);
#pragma unroll
    for (int hd = 0; hd < 8; ++hd) {
      const unsigned* tk = P_TOPK + ((size_t)u0 * 8 + hd) * 32;
      ck1[hd] = tk[ci];
      ck2[hd] = tk[16 + cj];
    }
  }
  for (int idx = wave; idx < ntok; idx += nw) {
    const int u = (layer == 0) ? idx : (idx >> 13) * LKB + 256 + (idx & 8191);
    const int b = u / LKB, pp = u - b * LKB;
    const bool isctx = pp < 256;
    float xf[16];
    {
      xf[0] = bf_lo(cx0.x); xf[1] = bf_hi(cx0.x); xf[2] = bf_lo(cx0.y); xf[3] = bf_hi(cx0.y);
      xf[4] = bf_lo(cx0.z); xf[5] = bf_hi(cx0.z); xf[6] = bf_lo(cx0.w); xf[7] = bf_hi(cx0.w);
      xf[8] = bf_lo(cx1.x); xf[9] = bf_hi(cx1.x); xf[10] = bf_lo(cx1.y); xf[11] = bf_hi(cx1.y);
      xf[12] = bf_lo(cx1.z); xf[13] = bf_hi(cx1.z); xf[14] = bf_lo(cx1.w); xf[15] = bf_hi(cx1.w);
    }
    float xmx = 0.f;
#pragma unroll
    for (int i = 0; i < 16; ++i) xmx = fmaxf(xmx, fabsf(xf[i]));
    xmx = wave_max(xmx);
    const float xsc = (xmx > 1e-30f) ? 127.f / xmx : 1.f;
    const float x_inv = (xmx > 1e-30f) ? xmx * (1.f / 127.f) : 1.f;
    int xq[4];
#pragma unroll
    for (int k = 0; k < 4; ++k)
      xq[k] = (int)(((unsigned)__float2int_rn(xf[4 * k] * xsc) & 255u) | (((unsigned)__float2int_rn(xf[4 * k + 1] * xsc) & 255u) << 8) |
                    (((unsigned)__float2int_rn(xf[4 * k + 2] * xsc) & 255u) << 16) | (((unsigned)__float2int_rn(xf[4 * k + 3] * xsc) & 255u) << 24));
    unsigned* sru = (unsigned*)sr;
#pragma unroll
    for (int hd = 0; hd < 8; ++hd) {
      const unsigned k1 = ck1[hd], k2 = ck2[hd];
      const float s = __uint_as_float(k1) + __uint_as_float(k2);
      const int e = (int)((k1 & 127u) * 128u + (k2 & 127u));
      unsigned ob = __float_as_uint(s);
      ob ^= (ob & 0x80000000u) ? 0xffffffffu : 0x80000000u;
      const unsigned key = (lane < 50) ? ((ob & ~63u) | (unsigned)(63 - lane)) : 0u;
      sru[lane] = key;
      __builtin_amdgcn_wave_barrier();
      int rank = 0;
#pragma unroll
      for (int L4 = 0; L4 < 13; ++L4) {
        const u32x4 q4 = *(const u32x4*)(sru + 4 * L4);
        rank += (q4.x > key) ? 1 : 0;
        rank += (q4.y > key) ? 1 : 0;
        rank += (q4.z > key) ? 1 : 0;
        rank += (q4.w > key) ? 1 : 0;
      }
      __builtin_amdgcn_wave_barrier();
      if ((lane < 50) && (rank < 16)) { se[hd * 16 + rank] = e; sg[hd * 16 + rank] = s; }
    }
    __builtin_amdgcn_wave_barrier();
#pragma unroll
    for (int j = 0; j < 2; ++j) {
      const int idx = lane + 64 * j;
      const float sv = sg[idx], m0 = sg[idx & ~15];
      const float ex = exp2f((sv - m0) * LOG2E);
      float sm = ex;
      sm += __shfl_xor(sm, 1); sm += __shfl_xor(sm, 2); sm += __shfl_xor(sm, 4); sm += __shfl_xor(sm, 8);
      __builtin_amdgcn_wave_barrier();
      sg[idx] = ex * __builtin_amdgcn_rcpf(sm);
    }
    __builtin_amdgcn_wave_barrier();
    f32x2 xv[8], yv[8];
#pragma unroll
    for (int i = 0; i < 8; ++i) { xv[i].x = xf[2 * i]; xv[i].y = xf[2 * i + 1]; yv[i].x = 0.f; yv[i].y = 0.f; }
    const bool b5 = (lane & 32) != 0, b4 = (lane & 16) != 0, b3 = (lane & 8) != 0;
    {
      const int idxn = min(idx + nw, ntok - 1);
      const int un = (layer == 0) ? idxn : (idxn >> 13) * LKB + 256 + (idxn & 8191);
      cx0 = *(const u32x4*)(P_H + (size_t)un * 1024 + lane * 16);
      cx1 = *(const u32x4*)(P_H + (size_t)un * 1024 + lane * 16 + 8);
#pragma unroll
      for (int hd = 0; hd < 8; ++hd) {
        const unsigned* tk = P_TOPK + ((size_t)un * 8 + hd) * 32;
        ck1[hd] = tk[ci];
        ck2[hd] = tk[16 + cj];
      }
    }
    const int mr = isctx ? 4 : b;
    const float* gate = P_MOD + (layer * 5 + mr) * 6144 + 5 * 1024;
    const float* rsrc = P_R + (size_t)u * 1024;
    float4 rv4[4], gv4[4];
#pragma unroll
    for (int q = 0; q < 4; ++q) {
      rv4[q] = *(const float4*)(rsrc + lane * 16 + q * 4);
      gv4[q] = *(const float4*)(gate + lane * 16 + q * 4);
    }
    {
      u32x4 urA[8], urB[8];
      u32x2 vrA[8], vrB[8];
      float sA, vA, gA, sB, vB, gB;
      peer_batch_load(p, se, sg, 0, lane, urA, vrA, sA, vA, gA);
#pragma unroll 1
      for (int eb = 0; eb < 16; eb += 2) {
        peer_batch_load(p, se, sg, eb + 1, lane, urB, vrB, sB, vB, gB);
        __builtin_amdgcn_sched_barrier(0);
        peer_batch_compute(urA, vrA, sA * x_inv, vA, gA, xq, yv, lane);
        peer_batch_load(p, se, sg, min(eb + 2, 15), lane, urA, vrA, sA, vA, gA);
        __builtin_amdgcn_sched_barrier(0);
        peer_batch_compute(urB, vrB, sB * x_inv, vB, gB, xq, yv, lane);
      }
    }
    float y[16];
#pragma unroll
    for (int i = 0; i < 8; ++i) { y[2 * i] = yv[i].x; y[2 * i + 1] = yv[i].y; }
    __builtin_amdgcn_wave_barrier();
    float* dst = (layer == 0) ? P_R + (size_t)u * 1024 : p.out + ((size_t)b * 8192 + (pp - 256)) * 1024;
    float4 ov[4];
    float ss = 0.f;
#pragma unroll
    for (int q = 0; q < 4; ++q) {
      const int col = lane * 16 + q * 4;
      const float4 rv = rv4[q];
      const float4 gv = gv4[q];
      float4 o;
      o.x = rv.x + gv.x * y[q * 4 + 0];
      o.y = rv.y + gv.y * y[q * 4 + 1];
      o.z = rv.z + gv.z * y[q * 4 + 2];
      o.w = rv.w + gv.w * y[q * 4 + 3];
      *(float4*)(dst + col) = o;
      ov[q] = o;
      ss += o.x * o.x + o.y * o.y + o.z * o.z + o.w * o.w;
    }
    if (layer == 0) {
      ss = wave_sum(ss);
      const float rn = rsqrtf(ss * (1.f / 1024.f) + 1e-6f);
      const float* g1 = p.norm_g + 2 * 1024;
      const float* shift = P_MOD + (5 + mr) * 6144;
      const float* scale = shift + 1024;
#pragma unroll
      for (int q = 0; q < 4; ++q) {
        const int col = lane * 16 + q * 4;
        const float4 g4 = *(const float4*)(g1 + col), sc = *(const float4*)(scale + col), sh = *(const float4*)(shift + col);
        const float y0 = ov[q].x * rn * g4.x * (1.f + sc.x) + sh.x;
        const float y1 = ov[q].y * rn * g4.y * (1.f + sc.y) + sh.y;
        const float y2 = ov[q].z * rn * g4.z * (1.f + sc.z) + sh.z;
        const float y3 = ov[q].w * rn * g4.w * (1.f + sc.w) + sh.w;
        *(uint2*)(P_H + (size_t)u * 1024 + col) = make_uint2(pack2(y0, y1), pack2(y2, y3));
      }
    }
  }
}

__global__ void __launch_bounds__(256, 2) fwd_mega(Params p) {
  cg::grid_group grid = cg::this_grid();
  __shared__ __attribute__((aligned(16))) char smem[SMEM_BYTES];
  volatile LAS unsigned* xb_st = (volatile LAS unsigned*)(smem + SMEM_BYTES - 16);
  if (threadIdx.x == 0) { xb_st[0] = 0u; xb_st[1] = 0u; }
  __syncthreads();
  const XcdBarrier xb = xcd_barrier_post(P_BAR, xb_st);
  phase_prologue(p, smem);
  xcd_barrier(xb);
  if (p.out == nullptr) grid.sync();
  for (int layer = 0; layer < 2; ++layer) {
    if (layer == 0) {
      phase_norm(p, 0, 0);
      xcd_barrier(xb);
    }
    phase_qkv(p, layer, smem);
    xcd_barrier(xb);
    if (layer == 0) phase_attn_l0(p, smem); else phase_attn_l1(p, smem);
    xcd_barrier(xb);
    phase_outproj(p, layer, smem);
    convert_i8_rows(p.peer_u + (size_t)layer * 16384 * 1024, P_U8, P_UIS);
    convert_fp4_rows(p.peer_v + (size_t)layer * 16384 * 1024, P_V8, P_VIS);
    xcd_barrier(xb);
    phase_norm(p, layer, 1);
    xcd_barrier(xb);
    phase_peerq(p, layer, smem);
    xcd_barrier(xb);
    phase_peer_final(p, layer, smem);
    if (layer == 0) xcd_barrier(xb);
  }
}

extern "C" void kernel_launch(void* const* d_in, const int* in_sizes, int n_in, void* d_out, int out_size, void* d_ws,
                              size_t ws_size, hipStream_t stream) {
  static int grid_blocks = 0;
  if (!grid_blocks) {
    int dev = 0, cus = 0, per_cu = 0;
    (void)hipGetDevice(&dev);
    (void)hipDeviceGetAttribute(&cus, hipDeviceAttributeMultiprocessorCount, dev);
    (void)hipOccupancyMaxActiveBlocksPerMultiprocessor(&per_cu, fwd_mega, 256, 0);
    if (per_cu > 2) per_cu = 2;
    if (per_cu < 1) per_cu = 1;
    grid_blocks = cus * per_cu;
    grid_blocks &= ~7;
  }
  Params p{};
  const float* const* in = (const float* const*)d_in;
  p.x = in[0]; p.c = in[1]; p.ctx = in[2]; p.c_ctx = in[3]; p.ada_w = in[4]; p.ada_b = in[5]; p.norm_g = in[6];
  p.ab_w_in = in[7]; p.ab_w_out = in[8]; p.a_qn = in[9]; p.a_kn = in[10]; p.b_qn = in[11]; p.b_kn = in[12]; p.b_lam = in[13];
  p.b_subln = in[14]; p.c_w_in = in[15]; p.c_w_out = in[16]; p.c_qn = in[17]; p.c_kn = in[18]; p.c_rpb = in[19];
  p.peer_wq = in[20]; p.peer_keys = in[21]; p.peer_u = in[22]; p.peer_v = in[23];
  p.out = (float*)d_out;
  p.ws = (char*)d_ws;
  if (WS_TOTAL > ws_size) { fprintf(stderr, "workspace too small: need %zu have %zu\n", (size_t)WS_TOTAL, ws_size); return; }
  (void)hipMemsetAsync((char*)d_ws + OFF_BAR, 0, 16384, stream);
  void* args[] = {&p};
  hipError_t e = hipLaunchCooperativeKernel((void*)fwd_mega, dim3(grid_blocks), dim3(256), args, 0, stream);
  if (e != hipSuccess) fprintf(stderr, "cooperative launch failed: %s (grid %d)\n", hipGetErrorString(e), grid_blocks);
}
```
